# Optimizing an MI355X kernel written in HIP

```python
import math
import jax
import jax.numpy as jnp
from jax import lax
import numpy as np

D_MODEL = 1024
BATCH = 8
SEQ = 4096
DEPTH = 4

N_EVEN = (DEPTH + 1) // 2
N_ODD = DEPTH // 2
HEAD_DIM = 64
CONV_W = 3
A_W = D_MODEL // 2
B_W = D_MODEL - A_W
POOL_WINDOWS = (2, 4, 8, 16)
N_POOL = len(POOL_WINDOWS)
POOL_G = B_W // N_POOL
EV_IN_W = 3 * A_W + B_W
MIX_W = A_W + B_W
H_FOX = D_MODEL // (2 * HEAD_DIM)
H_MOBA = D_MODEL // (2 * HEAD_DIM)
H_ATT = H_FOX + H_MOBA
ATT_W = H_ATT * HEAD_DIM
OD_IN_W = 3 * ATT_W + H_FOX
ATTN_SCALE = HEAD_DIM ** -0.5
FOX_Q_BLOCK = 128
MOBA_BLOCK = 256
MOBA_TOPK = 3
MOBA_Q_CHUNK = 32
T5_BUCKETS = 32
T5_MAX_DIST = 128
FORGET_BIAS_INIT = 2.0
D_FF = 2816
RMS_EPS = 1e-6

kernel_name = "hybrid_conv_pool_fox_moba_trunk"


def rmsnorm(x, g):
    xf = x.astype(jnp.float32)
    y = xf * lax.rsqrt(jnp.mean(xf * xf, axis=-1, keepdims=True) + RMS_EPS)
    return (y * g.astype(jnp.float32)).astype(x.dtype)


def causal_dwconv(u, w):
    s = u.shape[1]
    up = jnp.pad(u, ((0, 0), (CONV_W - 1, 0), (0, 0)))
    return sum(w[i] * up[:, i:i + s] for i in range(CONV_W))


def multiscale_pool(u, pool_w, pool_scale):
    bsz, s, _ = u.shape
    cs = jnp.cumsum(jnp.pad(u.astype(jnp.float32), ((0, 0), (1, 0), (0, 0))), axis=1)
    pos = jnp.arange(s)
    groups = []
    for g, w in enumerate(POOL_WINDOWS):
        csg = cs[..., g * POOL_G:(g + 1) * POOL_G]
        hi = csg[:, 1:]
        lo = jnp.pad(csg[:, :s + 1 - w], ((0, 0), (w - 1, 0), (0, 0)))
        cnt = jnp.minimum(pos + 1, w).astype(jnp.float32)[None, :, None]
        groups.append((hi - lo) / cnt - u[..., g * POOL_G:(g + 1) * POOL_G].astype(jnp.float32))
    p = jnp.stack(groups, axis=2).astype(u.dtype)
    y = jnp.einsum('bsgc,gcd->bsgd', p, pool_w).reshape(bsz, s, B_W)
    return y * pool_scale


def even_mixer(h, w_in, conv_w, pool_w, pool_scale, w_out):
    z = h @ w_in
    gate_b = z[..., :A_W]
    gate_c = z[..., A_W:2 * A_W]
    val = z[..., 2 * A_W:3 * A_W]
    pool_in = z[..., 3 * A_W:]
    y_a = gate_b * causal_dwconv(gate_c * val, conv_w)
    y_b = multiscale_pool(pool_in, pool_w, pool_scale)
    return jnp.concatenate([y_a, y_b], axis=-1) @ w_out


def t5_bucket(dist):
    dist = jnp.maximum(dist, 0)
    exact = T5_BUCKETS // 2
    d_f = jnp.maximum(dist, 1).astype(jnp.float32)
    log_b = exact + (jnp.log(d_f / exact) / math.log(T5_MAX_DIST / exact)
                     * (T5_BUCKETS - exact)).astype(jnp.int32)
    log_b = jnp.minimum(log_b, T5_BUCKETS - 1)
    return jnp.where(dist < exact, dist, log_b)


def forgetting_attention(q, k, v, log_f):
    bsz, nh, s, dh = q.shape
    fcum = jnp.cumsum(log_f, axis=-1)
    nq = s // FOX_Q_BLOCK
    q_blocks = q.reshape(bsz, nh, nq, FOX_Q_BLOCK, dh).transpose(2, 0, 1, 3, 4)
    f_blocks = fcum.reshape(bsz, nh, nq, FOX_Q_BLOCK).transpose(2, 0, 1, 3)
    kpos = jnp.arange(s)

    def one_block(args):
        i, q_i, f_i = args
        qpos = i * FOX_Q_BLOCK + jnp.arange(FOX_Q_BLOCK)
        logits = jnp.einsum('bhqd,bhkd->bhqk', q_i, k).astype(jnp.float32) * ATTN_SCALE
        logits = logits + f_i[..., :, None] - fcum[..., None, :]
        logits = jnp.where(kpos[None, :] <= qpos[:, None], logits, -jnp.inf)
        p = jax.nn.softmax(logits, axis=-1)
        return jnp.einsum('bhqk,bhkd->bhqd', p.astype(v.dtype), v)

    out = lax.map(one_block, (jnp.arange(nq), q_blocks, f_blocks))
    return out.transpose(1, 2, 0, 3, 4).reshape(bsz, nh, s, dh)


def moba_attention(q, k, v, rel_bias):
    bsz, nh, s, dh = q.shape
    n_blk = -(-s // MOBA_BLOCK)
    pad = n_blk * MOBA_BLOCK - s
    k_p = jnp.pad(k, ((0, 0), (0, 0), (0, pad), (0, 0)))
    v_p = jnp.pad(v, ((0, 0), (0, 0), (0, pad), (0, 0)))
    k_blk = k_p.reshape(bsz, nh, n_blk, MOBA_BLOCK, dh)
    v_blk = v_p.reshape(bsz, nh, n_blk, MOBA_BLOCK, dh)
    k_mean = jnp.mean(k_blk.astype(jnp.float32), axis=3)
    topk = min(MOBA_TOPK, n_blk)
    nq = s // MOBA_Q_CHUNK
    q_chunks = q.reshape(bsz, nh, nq, MOBA_Q_CHUNK, dh).transpose(2, 0, 1, 3, 4)
    blk_ids = jnp.arange(n_blk)
    kpos_in_blk = jnp.arange(MOBA_BLOCK)
    head_ids = jnp.arange(nh)[:, None, None, None]
    bias_t = rel_bias.T
    gather_blocks = jax.vmap(jax.vmap(lambda kb, ix: kb[ix]))

    def one_chunk(args):
        c, q_i = args
        start = c * MOBA_Q_CHUNK
        cur = start // MOBA_BLOCK
        qpos = start + jnp.arange(MOBA_Q_CHUNK)
        gate = jnp.einsum('bhqd,bhnd->bhqn', q_i.astype(jnp.float32), k_mean)
        gate = jnp.where(blk_ids < cur, gate, -jnp.inf)
        _, idx = lax.top_k(gate, topk)
        valid = idx < cur
        k_sel = gather_blocks(k_blk, idx)
        v_sel = gather_blocks(v_blk, idx)
        kpos_sel = idx[..., None] * MOBA_BLOCK + kpos_in_blk
        bias_sel = bias_t[head_ids, t5_bucket(qpos[:, None, None] - kpos_sel)]
        l_sel = jnp.einsum('bhqd,bhqtld->bhqtl', q_i, k_sel).astype(jnp.float32) * ATTN_SCALE
        l_sel = jnp.where(valid[..., None], l_sel + bias_sel, -jnp.inf)
        k_own = lax.dynamic_slice_in_dim(k_p, cur * MOBA_BLOCK, MOBA_BLOCK, axis=2)
        v_own = lax.dynamic_slice_in_dim(v_p, cur * MOBA_BLOCK, MOBA_BLOCK, axis=2)
        kpos_own = cur * MOBA_BLOCK + kpos_in_blk
        dist_own = qpos[:, None] - kpos_own[None, :]
        bias_own = rel_bias[t5_bucket(dist_own)].transpose(2, 0, 1)
        l_own = jnp.einsum('bhqd,bhld->bhql', q_i, k_own).astype(jnp.float32) * ATTN_SCALE
        l_own = jnp.where(dist_own >= 0, l_own + bias_own, -jnp.inf)
        logits = jnp.concatenate(
            [l_sel.reshape(bsz, nh, MOBA_Q_CHUNK, topk * MOBA_BLOCK), l_own], axis=-1)
        p = jax.nn.softmax(logits, axis=-1).astype(v.dtype)
        p_sel = p[..., :topk * MOBA_BLOCK].reshape(bsz, nh, MOBA_Q_CHUNK, topk, MOBA_BLOCK)
        p_own = p[..., topk * MOBA_BLOCK:]
        return (jnp.einsum('bhqtl,bhqtld->bhqd', p_sel, v_sel)
                + jnp.einsum('bhql,bhld->bhqd', p_own, v_own))

    out = lax.map(one_chunk, (jnp.arange(nq), q_chunks))
    return out.transpose(1, 2, 0, 3, 4).reshape(bsz, nh, s, dh)


def odd_mixer(h, w_in, b_f, w_out, rel_bias):
    bsz, s, _ = h.shape
    z = h @ w_in
    qkv = z[..., :3 * ATT_W].reshape(bsz, s, 3, H_ATT, HEAD_DIM).transpose(2, 0, 3, 1, 4)
    q, k, v = qkv[0], qkv[1], qkv[2]
    log_f = jax.nn.log_sigmoid((z[..., 3 * ATT_W:] + b_f).astype(jnp.float32)).transpose(0, 2, 1)
    y_c = forgetting_attention(q[:, :H_FOX], k[:, :H_FOX], v[:, :H_FOX], log_f)
    y_d = moba_attention(q[:, H_FOX:], k[:, H_FOX:], v[:, H_FOX:], rel_bias)
    y = jnp.concatenate([y_c, y_d], axis=1).transpose(0, 2, 1, 3).reshape(bsz, s, ATT_W)
    return y @ w_out


def conv_ffn(h, w_in, conv_w, conv_b, w_out):
    z = h @ w_in
    u, g = z[..., :D_FF], z[..., D_FF:]
    a = causal_dwconv(u, conv_w) + conv_b
    return (jax.nn.silu(a) * g) @ w_out


def setup_inputs(seed: int = 0) -> dict:
    key = jax.random.key(seed)
    ks = jax.random.split(key, 17)
    f32 = jnp.float32

    def nrm(k, shape, scale):
        return jax.random.normal(k, shape, f32) * scale

    out_scale = (2 * DEPTH) ** -0.5
    return {
        "x": nrm(ks[0], (BATCH, SEQ, D_MODEL), 1.0),
        "mix_norm_g": 1.0 + nrm(ks[1], (DEPTH, D_MODEL), 0.05),
        "ffn_norm_g": 1.0 + nrm(ks[2], (DEPTH, D_MODEL), 0.05),
        "final_norm_g": 1.0 + nrm(ks[3], (D_MODEL,), 0.05),
        "ev_w_in": nrm(ks[4], (N_EVEN, D_MODEL, EV_IN_W), D_MODEL ** -0.5),
        "ev_conv_w": nrm(ks[5], (N_EVEN, CONV_W, A_W), CONV_W ** -0.5),
        "ev_pool_w": nrm(ks[6], (N_EVEN, N_POOL, POOL_G, POOL_G), POOL_G ** -0.5),
        "ev_pool_scale": 1.0 + nrm(ks[7], (N_EVEN, B_W), 0.1),
        "ev_w_out": nrm(ks[8], (N_EVEN, MIX_W, D_MODEL), MIX_W ** -0.5 * out_scale),
        "od_w_in": nrm(ks[9], (N_ODD, D_MODEL, OD_IN_W), D_MODEL ** -0.5),
        "od_b_f": FORGET_BIAS_INIT + nrm(ks[10], (N_ODD, H_FOX), 0.5),
        "od_w_out": nrm(ks[11], (N_ODD, ATT_W, D_MODEL), ATT_W ** -0.5 * out_scale),
        "rel_bias": nrm(ks[12], (T5_BUCKETS, H_MOBA), 0.5),
        "ffn_w_in": nrm(ks[13], (DEPTH, D_MODEL, 2 * D_FF), D_MODEL ** -0.5),
        "ffn_conv_w": nrm(ks[14], (DEPTH, CONV_W, D_FF), CONV_W ** -0.5),
        "ffn_conv_b": nrm(ks[15], (DEPTH, D_FF), 0.02),
        "ffn_w_out": nrm(ks[16], (DEPTH, D_FF, D_MODEL), D_FF ** -0.5 * out_scale),
    }


def reference(x, mix_norm_g, ffn_norm_g, final_norm_g, ev_w_in, ev_conv_w, ev_pool_w,
              ev_pool_scale, ev_w_out, od_w_in, od_b_f, od_w_out, rel_bias,
              ffn_w_in, ffn_conv_w, ffn_conv_b, ffn_w_out):
    h = x
    for layer in range(DEPTH):
        hn = rmsnorm(h, mix_norm_g[layer])
        if layer % 2 == 0:
            e = layer // 2
            h = h + even_mixer(hn, ev_w_in[e], ev_conv_w[e], ev_pool_w[e],
                               ev_pool_scale[e], ev_w_out[e])
        else:
            o = layer // 2
            h = h + odd_mixer(hn, od_w_in[o], od_b_f[o], od_w_out[o], rel_bias)
        h = h + conv_ffn(rmsnorm(h, ffn_norm_g[layer]), ffn_w_in[layer],
                         ffn_conv_w[layer], ffn_conv_b[layer], ffn_w_out[layer])
    return rmsnorm(h, final_norm_g)
```

```cpp
#include <hip/hip_runtime.h>
#include <hip/hip_cooperative_groups.h>
#include <cstdio>
#include <cstdint>
namespace cg = cooperative_groups;
namespace pg8 {
#define PG8_LAS __attribute__((address_space(3)))
typedef unsigned short bf16_t;
typedef short bf16x8 __attribute__((ext_vector_type(8)));
typedef float f32x4 __attribute__((ext_vector_type(4)));
typedef unsigned u32x4 __attribute__((ext_vector_type(4)));
constexpr int BM = 256, BK = 64, HALF = 128, HTB = HALF * BK * 2  , STAGE_BYTES = 8 * HTB, NXCD = 8, WGM = 8;

__host__ __device__ __forceinline__ int lds_byte(int r, int c) { const int st = (r >> 4) * 2 + (c >> 5), rr = r & 15, cc = c & 31, ob = rr * 64 + cc * 2; return st * 1024 + (ob ^ (((ob >> 9) & 1) << 5)); }
__host__ __device__ __forceinline__ void stage_rc(int b, int& R, int& C) { const int st = b / 1024, sb = b % 1024, swz = sb ^ (((sb >> 9) & 1) << 5); R = (st >> 1) * 16 + swz / 64; C = (st & 1) * 32 + (swz % 64) / 2; }
__host__ __device__ __forceinline__ int perm32(int rho) { const int n = rho >> 4, i = rho & 15; return 8 * (i >> 2) + 4 * n + (i & 3); }

struct Unit { int pm, pn; };
struct Gemm { const bf16_t* A; const bf16_t* Bt; int M, N, K; };

struct StaticOrder {
    int nM, nN, nwg, G, c;
    __host__ __device__ __forceinline__ void init(int M, int N, int G_, int c_) { nM = M / BM; nN = N / BM; nwg = nM * nN; G = G_; c = c_; }
    __host__ __device__ __forceinline__ bool next(int i, Unit& u) const {
        const long L = (long)i * G + c; if (L >= nwg) return false;
        int wgid = (int)L; { const int q = nwg / NXCD, r = nwg % NXCD, xcd = wgid % NXCD, off = wgid / NXCD; wgid = (xcd < r ? xcd * (q + 1) : r * (q + 1) + (xcd - r) * q) + off; }
        const int nig = WGM * nN, gid = wgid / nig, fm = gid * WGM, gsz = (nM - fm) < WGM ? (nM - fm) : WGM;
        u.pm = fm + ((wgid % nig) % gsz); u.pn = (wgid % nig) / gsz; return true;
    }
    __device__ __forceinline__ void a_ready(const Unit&) const {}
    __device__ __forceinline__ void done(const Unit&) const {}
};

__device__ __forceinline__ unsigned cvt_pk_bf16(float lo, float hi) { unsigned r; asm volatile("v_cvt_pk_bf16_f32 %0, %1, %2" : "=v"(r) : "v"(lo), "v"(hi)); return r; }
#ifdef TEST_NORSTD
#define TEST_RS(x) 1.0f
#else
#define TEST_RS(x) (x)
#endif
typedef unsigned u32x2 __attribute__((ext_vector_type(2)));
__device__ __forceinline__ float row_rstd(const float* ssq, int row) {
    const f32x4 a = *(const f32x4*)(ssq + (size_t)row * 4);
    return __builtin_amdgcn_rsqf(((a[0] + a[1]) + (a[2] + a[3])) * (1.0f / 1024.0f) + 1e-6f);
}
struct EpiScaleBf16 {
    static constexpr bool PERM = true, AFTER_DRAIN = false;
    bf16_t* O; int ldc; const float* ssq; int row_off;
    int split_cols; size_t split_stride; float scale0;
    int ftile; float* lf; const float* bfv;
    __device__ __forceinline__ void operator()(const f32x4 (&acc)[2][2][4][2], const Unit& u, int wr, int wc, int fr, int fq) const {
        asm volatile("" : "+v"(fr), "+v"(fq));
        const int row0 = u.pm * BM + wr * 64 + fr;
        if (u.pn == ftile) {
            if (wc == 0 && fq == 0) {
                f32x4 b0 = *(const f32x4*)(bfv), b1 = *(const f32x4*)(bfv + 4);
#pragma unroll
                for (int ai = 0; ai < 2; ++ai)
#pragma unroll
                    for (int m = 0; m < 4; ++m) { const int row = row0 + ai * HALF + m * 16 + row_off; const float rs = row_rstd(ssq, row);
                        f32x4 v0 = acc[ai][0][m][0] * rs + b0, v1 = acc[ai][0][m][1] * rs + b1; f32x4 o0, o1;
#pragma unroll
                        for (int c = 0; c < 4; ++c) { float x = v0[c] * 1.4426950408889634f; o0[c] = fminf(x, 0.f) - __builtin_amdgcn_logf(1.f + __builtin_amdgcn_exp2f(-fabsf(x))); x = v1[c] * 1.4426950408889634f; o1[c] = fminf(x, 0.f) - __builtin_amdgcn_logf(1.f + __builtin_amdgcn_exp2f(-fabsf(x))); }
                        *(f32x4*)(lf + (size_t)row * 8) = o0; *(f32x4*)(lf + (size_t)row * 8 + 4) = o1; asm volatile("" ::: "memory"); }
            }
            return;
        }
        int colt = u.pn * BM; bf16_t* base = O; float sc = 1.f;
        if (split_cols) { const int t = colt / split_cols; base += (size_t)t * split_stride; colt -= t * split_cols; if (t == 0) sc = scale0; }
        const int col0 = colt + wc * 32 + 8 * fq;
        float rsv[2][4];
#pragma unroll
        for (int ai = 0; ai < 2; ++ai)
#pragma unroll
            for (int m = 0; m < 4; ++m) rsv[ai][m] = row_rstd(ssq, row0 + ai * HALF + m * 16 + row_off) * sc;
#pragma unroll
        for (int ai = 0; ai < 2; ++ai)
#pragma unroll
            for (int m = 0; m < 4; ++m) { const int row = row0 + ai * HALF + m * 16; const float rs = rsv[ai][m]; bf16_t* rowp = base + (size_t)row * ldc + col0;
#pragma unroll
                for (int bj = 0; bj < 2; ++bj) { const f32x4 v0 = acc[ai][bj][m][0] * rs, v1 = acc[ai][bj][m][1] * rs;
                    u32x4 w; w.x = cvt_pk_bf16(v0[0], v0[1]); w.y = cvt_pk_bf16(v0[2], v0[3]); w.z = cvt_pk_bf16(v1[0], v1[1]); w.w = cvt_pk_bf16(v1[2], v1[3]);
                    *(u32x4*)(rowp + bj * HALF) = w; } asm volatile("" ::: "memory"); }
    }
};
struct EpiResid {
    static constexpr bool PERM = true, AFTER_DRAIN = false;
    const float* base32; bf16_t* hb; float* ssq; int row_off; PG8_LAS float* P;
    __device__ __forceinline__ void operator()(const f32x4 (&acc)[2][2][4][2], const Unit& u, int wr, int wc, int fr, int fq) const {
        asm volatile("" : "+v"(fr), "+v"(fq));
        const int row0 = row_off + u.pm * BM + wr * 64 + fr, col0 = u.pn * BM + wc * 32 + 8 * fq;
#pragma unroll
        for (int ai = 0; ai < 2; ++ai) {
            u32x4 hv4[4][2];
            if (!base32) {
#pragma unroll
                for (int m = 0; m < 4; ++m)
#pragma unroll
                    for (int bj = 0; bj < 2; ++bj) hv4[m][bj] = *(const u32x4*)(hb + (size_t)(row0 + ai * HALF + m * 16) * 1024 + col0 + bj * HALF);
            }
#pragma unroll
            for (int m = 0; m < 4; ++m) { const int row = row0 + ai * HALF + m * 16; const size_t off = (size_t)row * 1024 + col0; float s = 0.f;
#pragma unroll
                for (int bj = 0; bj < 2; ++bj) { f32x4 b0, b1;
                    if (base32) { b0 = *(const f32x4*)(base32 + off + bj * HALF); b1 = *(const f32x4*)(base32 + off + bj * HALF + 4); }
                    else { const u32x4 hv = hv4[m][bj];
                        b0 = (f32x4){__builtin_bit_cast(float, hv.x << 16), __builtin_bit_cast(float, hv.x & 0xffff0000u), __builtin_bit_cast(float, hv.y << 16), __builtin_bit_cast(float, hv.y & 0xffff0000u)};
                        b1 = (f32x4){__builtin_bit_cast(float, hv.z << 16), __builtin_bit_cast(float, hv.z & 0xffff0000u), __builtin_bit_cast(float, hv.w << 16), __builtin_bit_cast(float, hv.w & 0xffff0000u)}; }
                    const f32x4 o0 = b0 + acc[ai][bj][m][0], o1 = b1 + acc[ai][bj][m][1];
                    s += ((o0[0] * o0[0] + o0[1] * o0[1]) + (o0[2] * o0[2] + o0[3] * o0[3])) + ((o1[0] * o1[0] + o1[1] * o1[1]) + (o1[2] * o1[2] + o1[3] * o1[3]));
                    u32x4 w; w.x = cvt_pk_bf16(o0[0], o0[1]); w.y = cvt_pk_bf16(o0[2], o0[3]); w.z = cvt_pk_bf16(o1[0], o1[1]); w.w = cvt_pk_bf16(o1[2], o1[3]); *(u32x4*)(hb + off + bj * HALF) = w; }
                s += __shfl_xor(s, 16); s += __shfl_xor(s, 32);
                if (fq == 0) P[(wr * 64 + ai * HALF + m * 16 + fr) * 4 + wc] = s;
                asm volatile("" ::: "memory"); }
        }
        asm volatile("s_waitcnt lgkmcnt(0)" ::: "memory"); __builtin_amdgcn_s_barrier(); asm volatile("" ::: "memory");
        { const int t = (wr * 4 + wc) * 64 + fq * 16 + fr; if (t < 256) { const f32x4 v = *(const PG8_LAS f32x4*)(P + t * 4); ssq[(size_t)(row_off + u.pm * BM + t) * 4 + u.pn] = (v[0] + v[1]) + (v[2] + v[3]); } }
    }
};
__device__ __forceinline__ float dpp_shr1(float v) { return __builtin_bit_cast(float, __builtin_amdgcn_update_dpp(0, __builtin_bit_cast(int, v), 0x111, 0xf, 0xf, true)); }
__device__ __forceinline__ float dpp_shr2(float v) { return __builtin_bit_cast(float, __builtin_amdgcn_update_dpp(0, __builtin_bit_cast(int, v), 0x112, 0xf, 0xf, true)); }
__device__ __forceinline__ float dpp_ror1(float v) { return __builtin_bit_cast(float, __builtin_amdgcn_update_dpp(0, __builtin_bit_cast(int, v), 0x121, 0xf, 0xf, false)); }
__device__ __forceinline__ float dpp_shl15(float v) { return __builtin_bit_cast(float, __builtin_amdgcn_update_dpp(0, __builtin_bit_cast(int, v), 0x10F, 0xf, 0xf, true)); }
__device__ __forceinline__ float dpp_shl14(float v) { return __builtin_bit_cast(float, __builtin_amdgcn_update_dpp(0, __builtin_bit_cast(int, v), 0x10E, 0xf, 0xf, true)); }
__device__ __forceinline__ float dpp_ror2(float v) { return __builtin_bit_cast(float, __builtin_amdgcn_update_dpp(0, __builtin_bit_cast(int, v), 0x122, 0xf, 0xf, false)); }
struct EpiFfnAct {
    static constexpr bool PERM = true, AFTER_DRAIN = false;
    bf16_t* act; const float* ssq; const float* cw; const float* cb; float* UH; float* AP; float* GP; PG8_LAS float* X;
    __device__ __forceinline__ void operator()(const f32x4 (&acc)[2][2][4][2], const Unit& u, int wr, int wc, int fr, int fq) const {
        asm volatile("" : "+v"(fr), "+v"(fq));
        constexpr int FF = 2816;
        const int wid = wr * 4 + wc, cl = 32 * wc + 8 * fq, col = u.pn * 128 + cl, row0 = u.pm * BM + wr * 64 + fr;
        const float rs3[2] = {row_rstd(ssq, row0 + 48), row_rstd(ssq, row0 + HALF + 48)};
#pragma unroll
        for (int ai = 0; ai < 2; ++ai) { const float rs = rs3[ai];
            if (fr >= 14) { const f32x4 a = acc[ai][0][3][0] * rs, b = acc[ai][0][3][1] * rs; PG8_LAS f32x4* xp = (PG8_LAS f32x4*)(X + ((wid * 2 + ai) * 2 + (fr - 14)) * 32 + fq * 8); xp[0] = a; xp[1] = b;
                if (wr == 1 && ai == 1) { float* g = UH + ((size_t)u.pm * 2 + (fr - 14)) * FF + col; *(f32x4*)g = a; *(f32x4*)(g + 4) = b; } } }
        asm volatile("s_waitcnt lgkmcnt(0)" ::: "memory"); __builtin_amdgcn_s_barrier(); asm volatile("" ::: "memory");
        const f32x4 w0a = *(const f32x4*)(cw + col), w0b = *(const f32x4*)(cw + col + 4), w1a = *(const f32x4*)(cw + FF + col), w1b = *(const f32x4*)(cw + FF + col + 4);
        const f32x4 w2a = *(const f32x4*)(cw + 2 * FF + col), w2b = *(const f32x4*)(cw + 2 * FF + col + 4), ba = *(const f32x4*)(cb + col), bb = *(const f32x4*)(cb + col + 4);
        const float m0 = (fr == 0) ? 1.f : 0.f, m1 = (fr == 1) ? 1.f : 0.f;
#pragma unroll
        for (int ai = 0; ai < 2; ++ai) {
            f32x4 pa = {0.f, 0.f, 0.f, 0.f}, pb = {0.f, 0.f, 0.f, 0.f};
            float rsv[4];
#pragma unroll
            for (int m = 0; m < 4; ++m) rsv[m] = row_rstd(ssq, row0 + ai * HALF + m * 16);
#pragma unroll
            for (int m = 0; m < 4; ++m) {
                const int row = row0 + ai * HALF + m * 16; const float rs = rsv[m];
                const f32x4 ca = acc[ai][0][m][0] * rs, cb_ = acc[ai][0][m][1] * rs;
                f32x4 aa = w2a * ca + ba, ab = w2b * cb_ + bb;
#pragma unroll
                for (int c = 0; c < 4; ++c) { aa[c] = __builtin_fmaf(w1a[c], dpp_shr1(ca[c]), aa[c]); ab[c] = __builtin_fmaf(w1b[c], dpp_shr1(cb_[c]), ab[c]);
                    aa[c] = __builtin_fmaf(w0a[c], dpp_shr2(ca[c]), aa[c]); ab[c] = __builtin_fmaf(w0b[c], dpp_shr2(cb_[c]), ab[c]); }
                if (m == 0) {
                    if (ai == 1 || wr == 1) { const int sw = ((ai == 1 && wr == 0) ? 4 : 0) + wc, sai = (ai == 1 && wr == 1) ? 1 : 0;
                        const PG8_LAS f32x4* xp = (const PG8_LAS f32x4*)(X + ((sw * 2 + sai) * 2) * 32 + fq * 8); const f32x4 h0a = xp[0], h0b = xp[1], h1a = xp[8], h1b = xp[9];
                        aa += w1a * (h1a * m0) + w0a * (h0a * m0 + h1a * m1); ab += w1b * (h1b * m0) + w0b * (h0b * m0 + h1b * m1); }
                } else {
#pragma unroll
                    for (int c = 0; c < 4; ++c) { aa[c] = __builtin_fmaf(w1a[c], dpp_shl15(pa[c]), aa[c]); ab[c] = __builtin_fmaf(w1b[c], dpp_shl15(pb[c]), ab[c]);
                        aa[c] = __builtin_fmaf(w0a[c], dpp_shl14(pa[c]), aa[c]); ab[c] = __builtin_fmaf(w0b[c], dpp_shl14(pb[c]), ab[c]); }
                }
                const f32x4 ga = acc[ai][1][m][0] * rs, gb = acc[ai][1][m][1] * rs;
                f32x4 ea = aa * -1.4426950408889634f, eb = ab * -1.4426950408889634f;
#pragma unroll
                for (int c = 0; c < 4; ++c) { ea[c] = __builtin_amdgcn_exp2f(ea[c]); eb[c] = __builtin_amdgcn_exp2f(eb[c]); }
                ea = ea + 1.0f; eb = eb + 1.0f;
#pragma unroll
                for (int c = 0; c < 4; ++c) { ea[c] = __builtin_amdgcn_rcpf(ea[c]); eb[c] = __builtin_amdgcn_rcpf(eb[c]); }
                const f32x4 oa = (aa * ga) * ea, ob = (ab * gb) * eb;
                u32x4 w; w.x = cvt_pk_bf16(oa[0], oa[1]); w.y = cvt_pk_bf16(oa[2], oa[3]); w.z = cvt_pk_bf16(ob[0], ob[1]); w.w = cvt_pk_bf16(ob[2], ob[3]);
                *(u32x4*)(act + (size_t)row * FF + col) = w;
                if (m == 0 && ai == 0 && wr == 0 && fr < 2 && (u.pm & 15) != 0) { float* g = AP + ((size_t)u.pm * 2 + fr) * FF + col; *(f32x4*)g = aa; *(f32x4*)(g + 4) = ab;
                    float* g2 = GP + ((size_t)u.pm * 2 + fr) * FF + col; *(f32x4*)g2 = ga; *(f32x4*)(g2 + 4) = gb; }
                pa = ca; pb = cb_;
                asm volatile("" ::: "memory");
            }
        }
    }
};
template <class Epi, class Sched, bool ALIGN_EPI = false, bool SP2 = false>
__device__ __forceinline__ void gemm_phase(PG8_LAS unsigned char* lds, const Gemm g, const Sched& S, const Epi& E) {
    int tid_ = threadIdx.x; asm volatile("" : "+v"(tid_));
    const int tid = tid_, wid = __builtin_amdgcn_readfirstlane(tid >> 6), lane = tid & 63, wr = wid >> 2, wc = wid & 3, fr = lane & 15, fq = lane >> 4;
    const int K = g.K, nt = K / BK;
    unsigned voffA[2], voffB[2];
#pragma unroll
    for (int i = 0; i < 2; ++i) { int R, C; stage_rc(tid * 16 + i * 8192, R, C); const int Rb = Epi::PERM ? ((R & ~31) + perm32(R & 31)) : R;
        voffA[i] = (unsigned)(R * K + C) * 2u; voffB[i] = (unsigned)(Rb * K + C) * 2u; }
    const size_t kstep = (size_t)(BK * 2);
    const size_t hstep = (size_t)HALF * K * 2;
    const size_t tstep = 2 * hstep;
    const unsigned ldsw = (unsigned)wid * 1024u;
    const int aoff = lds_byte(wr * 64 + fr, fq * 8), boff = lds_byte(wc * 32 + fr, fq * 8);
#define PG8_SA(b, h) (((b) * 2 + (h)) * HTB)
#define PG8_SB(b, h) ((4 + (b) * 2 + (h)) * HTB)
#define PG8_STAGE(bufoff, gbase, voff) do { _Pragma("unroll") for (int _i = 0; _i < 2; ++_i) \
        __builtin_amdgcn_global_load_lds((const unsigned*)((const char*)(gbase) + (voff)[_i]), (PG8_LAS unsigned*)(lds + (bufoff) + ldsw + _i * 8192), 16, 0, 0); } while (0)
#define PG8_LDA(dst, b, h) do { _Pragma("unroll") for (int m = 0; m < 4; ++m) _Pragma("unroll") for (int k = 0; k < 2; ++k) dst[m][k] = *(const PG8_LAS bf16x8*)(lds + PG8_SA(b, h) + aoff + m * 2048 + k * 1024); } while (0)
#define PG8_LDB(dst, b, h) do { _Pragma("unroll") for (int n = 0; n < 2; ++n) _Pragma("unroll") for (int k = 0; k < 2; ++k) dst[n][k] = *(const PG8_LAS bf16x8*)(lds + PG8_SB(b, h) + boff + n * 2048 + k * 1024); } while (0)
#define PG8_MMA(ai, bj, At, Bt) do { __builtin_amdgcn_s_setprio(1); _Pragma("unroll") for (int m = 0; m < 4; ++m) _Pragma("unroll") for (int n = 0; n < 2; ++n) _Pragma("unroll") for (int k = 0; k < 2; ++k) \
        acc[ai][bj][m][n] = __builtin_amdgcn_mfma_f32_16x16x32_bf16(Bt[n][k], At[m][k], acc[ai][bj][m][n], 0, 0, 0); __builtin_amdgcn_s_setprio(0); } while (0)
#define PG8_WAIT_V(n) asm volatile("s_waitcnt vmcnt(" #n ")" ::: "memory")
#define PG8_WAIT_L(n) asm volatile("s_waitcnt lgkmcnt(" #n ")" ::: "memory")
#define PG8_BAR __builtin_amdgcn_s_barrier()
#define PG8_SCHED __builtin_amdgcn_sched_barrier(0)
    Unit cur, nxt; int ui = 0;
    if (!S.next(0, cur)) return;
    f32x4 acc[2][2][4][2];
#pragma unroll
    for (int a = 0; a < 2; ++a)
#pragma unroll
        for (int b = 0; b < 2; ++b)
#pragma unroll
            for (int m = 0; m < 4; ++m)
#pragma unroll
                for (int n = 0; n < 2; ++n) acc[a][b][m][n] = (f32x4){0.f, 0.f, 0.f, 0.f};
    bf16x8 At[4][2], B0[2][2], B1[2][2];
    const char* cA = (const char*)g.A + (size_t)cur.pm * tstep; const char* cB = (const char*)g.Bt + (size_t)cur.pn * tstep;
    S.a_ready(cur);
    if constexpr (SP2) {
        PG8_STAGE(PG8_SB(0, 0), cB, voffB); PG8_STAGE(PG8_SB(0, 1), cB + hstep, voffB); PG8_STAGE(PG8_SA(0, 0), cA, voffA); PG8_STAGE(PG8_SA(0, 1), cA + hstep, voffA);
        if (wr == 1) PG8_BAR;
        PG8_WAIT_V(2); PG8_BAR;
        PG8_STAGE(PG8_SB(1, 0), cB + kstep, voffB); PG8_STAGE(PG8_SA(1, 0), cA + kstep, voffA); PG8_STAGE(PG8_SB(1, 1), cB + hstep + kstep, voffB);
        PG8_WAIT_V(6); PG8_BAR;
    } else {
        PG8_STAGE(PG8_SB(0, 0), cB, voffB); PG8_STAGE(PG8_SA(0, 0), cA, voffA); PG8_STAGE(PG8_SB(0, 1), cB + hstep, voffB); PG8_STAGE(PG8_SA(0, 1), cA + hstep, voffA);
        if (wr == 1) PG8_BAR;
        PG8_WAIT_V(4); PG8_BAR;
        PG8_STAGE(PG8_SB(1, 0), cB + kstep, voffB); PG8_STAGE(PG8_SA(1, 0), cA + kstep, voffA); PG8_STAGE(PG8_SB(1, 1), cB + hstep + kstep, voffB);
        PG8_WAIT_V(6); PG8_BAR;
    }
    for (;;) {
        const bool has_next = S.next(ui + 1, nxt);
        const char* nA = has_next ? (const char*)g.A + (size_t)nxt.pm * tstep : cA; const char* nB = has_next ? (const char*)g.Bt + (size_t)nxt.pn * tstep : cB;
        for (int t = 0; t < nt; t += 2) {
            const bool last = (t == nt - 2);
            const char* a1 = cA + (size_t)(t + 1) * kstep;
            const char* a2 = last ? nA : cA + (size_t)(t + 2) * kstep; const char* b2 = last ? nB : cB + (size_t)(t + 2) * kstep;
            const char* a3 = a2 + kstep; const char* b3 = b2 + kstep;
            if (last && has_next) S.a_ready(nxt);
            if constexpr (SP2) {
            PG8_LDB(B0, 0, 0); PG8_LDB(B1, 0, 1); PG8_SCHED; PG8_LDA(At, 0, 0); PG8_STAGE(PG8_SA(1, 1), a1 + hstep, voffA);
            PG8_WAIT_V(8); PG8_WAIT_L(0); PG8_BAR; PG8_MMA(0, 0, At, B0); PG8_MMA(0, 1, At, B1); PG8_BAR; PG8_SCHED;
            PG8_LDA(At, 0, 1); PG8_STAGE(PG8_SB(0, 0), b2, voffB); PG8_STAGE(PG8_SB(0, 1), b2 + hstep, voffB); PG8_STAGE(PG8_SA(0, 0), a2, voffA);
            PG8_WAIT_V(8); PG8_WAIT_L(0); PG8_BAR; PG8_MMA(1, 0, At, B0); PG8_MMA(1, 1, At, B1); PG8_BAR; PG8_SCHED;
            PG8_LDB(B0, 1, 0); PG8_LDB(B1, 1, 1); PG8_SCHED; PG8_LDA(At, 1, 0); PG8_STAGE(PG8_SA(0, 1), a2 + hstep, voffA);
            PG8_WAIT_V(8); PG8_WAIT_L(0); PG8_BAR; PG8_MMA(0, 0, At, B0); PG8_MMA(0, 1, At, B1); PG8_BAR; PG8_SCHED;
            PG8_LDA(At, 1, 1); PG8_STAGE(PG8_SB(1, 0), b3, voffB); PG8_STAGE(PG8_SB(1, 1), b3 + hstep, voffB); PG8_STAGE(PG8_SA(1, 0), a3, voffA);
            PG8_WAIT_V(8); PG8_WAIT_L(0); PG8_BAR; PG8_MMA(1, 0, At, B0); PG8_MMA(1, 1, At, B1); PG8_BAR; PG8_SCHED;
            } else {
            PG8_LDB(B0, 0, 0); PG8_SCHED; PG8_LDA(At, 0, 0); PG8_STAGE(PG8_SA(1, 1), a1 + hstep, voffA);
            PG8_WAIT_L(8); PG8_BAR; PG8_WAIT_L(0); PG8_MMA(0, 0, At, B0); PG8_BAR; PG8_SCHED;
            PG8_LDB(B1, 0, 1); PG8_STAGE(PG8_SB(0, 0), b2, voffB);
            PG8_BAR; PG8_WAIT_L(0); PG8_MMA(0, 1, At, B1); PG8_BAR;
            PG8_LDA(At, 0, 1); PG8_STAGE(PG8_SA(0, 0), a2, voffA);
            PG8_BAR; PG8_WAIT_L(0); PG8_MMA(1, 0, At, B0); PG8_BAR; PG8_SCHED;
            PG8_STAGE(PG8_SB(0, 1), b2 + hstep, voffB);
            PG8_WAIT_V(6); PG8_BAR; PG8_MMA(1, 1, At, B1); PG8_BAR;
            PG8_LDB(B0, 1, 0); PG8_SCHED; PG8_LDA(At, 1, 0); PG8_STAGE(PG8_SA(0, 1), a2 + hstep, voffA);
            PG8_WAIT_L(8); PG8_BAR; PG8_WAIT_L(0); PG8_MMA(0, 0, At, B0); PG8_BAR; PG8_SCHED;
            PG8_LDB(B1, 1, 1); PG8_STAGE(PG8_SB(1, 0), b3, voffB);
            PG8_BAR; PG8_WAIT_L(0); PG8_MMA(0, 1, At, B1); PG8_BAR;
            PG8_LDA(At, 1, 1); PG8_STAGE(PG8_SA(1, 0), a3, voffA);
            PG8_BAR; PG8_WAIT_L(0); PG8_MMA(1, 0, At, B0); PG8_BAR; PG8_SCHED;
            PG8_STAGE(PG8_SB(1, 1), b3 + hstep, voffB);
            PG8_WAIT_V(6); PG8_BAR; PG8_MMA(1, 1, At, B1); PG8_BAR;
            }
        }
        if constexpr (ALIGN_EPI) { if (wr == 0) PG8_BAR; }
        if constexpr (!Epi::AFTER_DRAIN) { E(acc, cur, wr, wc, fr, fq); S.done(cur); }
        if (!has_next) break;
#pragma unroll
        for (int a = 0; a < 2; ++a)
#pragma unroll
            for (int b = 0; b < 2; ++b)
#pragma unroll
                for (int m = 0; m < 4; ++m)
#pragma unroll
                    for (int n = 0; n < 2; ++n) acc[a][b][m][n] = (f32x4){0.f, 0.f, 0.f, 0.f};
        cur = nxt; cA = nA; cB = nB; ++ui;
        if constexpr (ALIGN_EPI) { if (wr == 1) PG8_BAR; }
    }
    PG8_WAIT_V(0);
    if constexpr (!ALIGN_EPI) { if (wr == 0) PG8_BAR; }
    PG8_BAR;
    if constexpr (Epi::AFTER_DRAIN) { E.fused(acc, cur, wr, wc, fr, fq, lds, wid, lane); S.done(cur); }
#undef PG8_SA
#undef PG8_SB
#undef PG8_STAGE
#undef PG8_LDA
#undef PG8_LDB
#undef PG8_MMA
#undef PG8_WAIT_V
#undef PG8_WAIT_L
#undef PG8_BAR
#undef PG8_SCHED
}
}

typedef unsigned short bf16_t;
typedef short bf16x8 __attribute__((ext_vector_type(8)));
typedef float f32x4 __attribute__((ext_vector_type(4)));
typedef unsigned u32x4 __attribute__((ext_vector_type(4)));
typedef unsigned u32x2 __attribute__((ext_vector_type(2)));
#define LAS __attribute__((address_space(3)))
constexpr int MROWS = 32768, DM = 1024, SEQ = 4096, NB = 8, DFF = 2816;
constexpr int EV_N = 2048, OD_N = 3080, OD_NP = 3328, FF_N = 5632;
constexpr float LOG2E = 1.4426950408889634f;
constexpr int NTHREADS = 512, NWAVES = 8;
constexpr int LDS_BYTES = 163840;
constexpr size_t MiB = 1u << 20;
constexpr size_t WS_EVIN = 0, WS_EVOUT = 8 * MiB, WS_ODIN = 12 * MiB, WS_ODOUT = 25 * MiB, WS_FFIN = 29 * MiB, WS_FFOUT = 73 * MiB, WS_POOL = 95 * MiB;
constexpr size_t WS_KNT = 100 * MiB + 768 * 1024;
constexpr size_t WS_SSQ = 96 * MiB, WS_LF = 98 * MiB, WS_F2 = 99 * MiB, WS_KMEAN = 100 * MiB, WS_HB = 101 * MiB, WS_R2 = 165 * MiB, WS_R1 = 253 * MiB, WS_END = 445 * MiB;
constexpr int FF_HALVES = 2, MH = MROWS / FF_HALVES;

struct Params { const float* in[17]; float* out; unsigned char* ws; int ph_lo, ph_hi; };
enum { I_X = 0, I_MIXG, I_FFNG, I_FING, I_EVWIN, I_EVCONV, I_EVPOOLW, I_EVPOOLS, I_EVWOUT, I_ODWIN, I_ODBF, I_ODWOUT, I_RELB, I_FFWIN, I_FFCONVW, I_FFCONVB, I_FFWOUT };

__device__ __forceinline__ unsigned f2bf(float f) { unsigned u = __builtin_bit_cast(unsigned, f); return (u + 0x7fffu + ((u >> 16) & 1u)) >> 16; }
typedef float f32x2_t __attribute__((ext_vector_type(2))); typedef __bf16 bf16x2_t __attribute__((ext_vector_type(2)));
__device__ __forceinline__ unsigned pk2(float lo, float hi) { const f32x2_t v = {lo, hi}; const bf16x2_t b = __builtin_convertvector(v, bf16x2_t); return __builtin_bit_cast(unsigned, b); }
__device__ __forceinline__ float bf_lo(unsigned u) { return __builtin_bit_cast(float, u << 16); }
__device__ __forceinline__ float bf_hi(unsigned u) { return __builtin_bit_cast(float, u & 0xffff0000u); }
__device__ __forceinline__ float wave_sum(float v) {
#pragma unroll
    for (int o = 1; o < 64; o <<= 1) v += __shfl_xor(v, o);
    return v;
}

__device__ __forceinline__ void transpose_item(const float* W, int K, int N, int NP, bf16_t* WT, const float* gvec, int mode, float* scr, int item, int lane) {
    const int nblk = NP / 64, kb = item / nblk, nb = item % nblk, k0 = 64 * kb, n0 = 64 * nb;
    const int nq = 4 * (lane & 15), n = n0 + nq;
#pragma unroll 8
    for (int i = 0; i < 16; ++i) { const int kk = 4 * i + (lane >> 4);
        f32x4 v = {0.f, 0.f, 0.f, 0.f}; if (n < N) v = *(const f32x4*)(W + (size_t)(k0 + kk) * N + n); if (gvec) v = v * gvec[k0 + kk];
        float* d = scr + kk * 65 + nq; d[0] = v[0]; d[1] = v[1]; d[2] = v[2]; d[3] = v[3]; }
    asm volatile("s_waitcnt lgkmcnt(0)" ::: "memory");
    const int c = lane & 7;
#pragma unroll
    for (int j = 0; j < 8; ++j) { const int nl = (lane >> 3) + 8 * j; const float* sp = scr + (8 * c) * 65 + nl; int nn = n0 + nl;
        if (mode == 1) { nn = (nn < DFF) ? ((nn >> 7) * 256 + (nn & 127)) : ((((nn - DFF) >> 7) * 256) + 128 + ((nn - DFF) & 127)); }
        u32x4 o; o.x = pk2(sp[0 * 65], sp[1 * 65]); o.y = pk2(sp[2 * 65], sp[3 * 65]); o.z = pk2(sp[4 * 65], sp[5 * 65]); o.w = pk2(sp[6 * 65], sp[7 * 65]);
        *(u32x4*)(WT + (size_t)nn * K + k0 + 8 * c) = o; }
    asm volatile("s_waitcnt lgkmcnt(0)" ::: "memory");
}
__device__ __forceinline__ void phase_prologue(const Params& p, unsigned char* lds) {
    int tid_ = threadIdx.x; asm volatile("" : "+v"(tid_)); const int tid = tid_, lane = tid & 63, wave = tid >> 6;
    float* scr = (float*)(lds + wave * 16896);
    const int gw = blockIdx.x * NWAVES + wave, NGW = gridDim.x * NWAVES;
    unsigned char* ws = p.ws;
    constexpr int I_EI = 16 * (EV_N / 64), I_EO = 16 * 16, I_OI = 16 * (OD_NP / 64), I_OO = 16 * 16, I_FI = 16 * (FF_N / 64), I_FO = (DFF / 64) * 16, I_PW = 2 * 2;
    constexpr int NITEMS = 2 * I_EI + 2 * I_EO + 2 * I_OI + 2 * I_OO + 4 * I_FI + 4 * I_FO + 8 * I_PW;
    for (int it = gw; it < NITEMS; it += NGW) {
        int r = it;
        if (r < 2 * I_EI) { const int e = r / I_EI; transpose_item(p.in[I_EVWIN] + (size_t)e * DM * EV_N, DM, EV_N, EV_N, (bf16_t*)(ws + WS_EVIN) + (size_t)e * EV_N * DM, p.in[I_MIXG] + (2 * e) * DM, 0, scr, r % I_EI, lane); continue; } r -= 2 * I_EI;
        if (r < 2 * I_EO) { const int e = r / I_EO; transpose_item(p.in[I_EVWOUT] + (size_t)e * DM * DM, DM, DM, DM, (bf16_t*)(ws + WS_EVOUT) + (size_t)e * DM * DM, nullptr, 0, scr, r % I_EO, lane); continue; } r -= 2 * I_EO;
        if (r < 2 * I_OI) { const int e = r / I_OI; transpose_item(p.in[I_ODWIN] + (size_t)e * DM * OD_N, DM, OD_N, OD_NP, (bf16_t*)(ws + WS_ODIN) + (size_t)e * OD_NP * DM, p.in[I_MIXG] + (2 * e + 1) * DM, 0, scr, r % I_OI, lane); continue; } r -= 2 * I_OI;
        if (r < 2 * I_OO) { const int e = r / I_OO; transpose_item(p.in[I_ODWOUT] + (size_t)e * DM * DM, DM, DM, DM, (bf16_t*)(ws + WS_ODOUT) + (size_t)e * DM * DM, nullptr, 0, scr, r % I_OO, lane); continue; } r -= 2 * I_OO;
        if (r < 4 * I_FI) { const int e = r / I_FI; transpose_item(p.in[I_FFWIN] + (size_t)e * DM * FF_N, DM, FF_N, FF_N, (bf16_t*)(ws + WS_FFIN) + (size_t)e * FF_N * DM, p.in[I_FFNG] + e * DM, 1, scr, r % I_FI, lane); continue; } r -= 4 * I_FI;
        if (r < 4 * I_FO) { const int e = r / I_FO; transpose_item(p.in[I_FFWOUT] + (size_t)e * DFF * DM, DFF, DM, DM, (bf16_t*)(ws + WS_FFOUT) + (size_t)e * DM * DFF, nullptr, 0, scr, r % I_FO, lane); continue; } r -= 4 * I_FO;
        { const int e = r / I_PW; transpose_item(p.in[I_EVPOOLW] + (size_t)e * 128 * 128, 128, 128, 128, (bf16_t*)(ws + WS_POOL) + (size_t)e * 128 * 128, nullptr, 0, scr, r % I_PW, lane); }
    }
    const float* x = p.in[I_X]; bf16_t* hb = (bf16_t*)(ws + WS_HB); float* ssq = (float*)(ws + WS_SSQ);
    { f32x4 nv[4];
      if (gw < MROWS) { const f32x4* xr = (const f32x4*)(x + (size_t)gw * DM) + lane;
#pragma unroll
          for (int j = 0; j < 4; ++j) nv[j] = xr[64 * j]; }
      for (int m = gw; m < MROWS; m += NGW) {
        f32x4 v[4]; float s = 0.f;
#pragma unroll
        for (int j = 0; j < 4; ++j) v[j] = nv[j];
        if (m + NGW < MROWS) { const f32x4* xr = (const f32x4*)(x + (size_t)(m + NGW) * DM) + lane;
#pragma unroll
            for (int j = 0; j < 4; ++j) nv[j] = xr[64 * j]; }
#pragma unroll
        for (int j = 0; j < 4; ++j) s += (v[j][0] * v[j][0] + v[j][1] * v[j][1]) + (v[j][2] * v[j][2] + v[j][3] * v[j][3]);
        s = wave_sum(s);
        u32x2* o8 = (u32x2*)(hb + (size_t)m * DM) + lane;
#pragma unroll
        for (int j = 0; j < 4; ++j) { u32x2 w; w.x = pk2(v[j][0], v[j][1]); w.y = pk2(v[j][2], v[j][3]); o8[64 * j] = w; }
        if (lane < 4) ssq[(size_t)m * 4 + lane] = (lane == 0) ? s : 0.f;
      } }
}

__device__ __forceinline__ void phase_evmix(const Params& p, unsigned char* lds, int e) {
    int tid_ = threadIdx.x; asm volatile("" : "+v"(tid_)); const int tid = tid_, lane = tid & 63, wave = tid >> 6, fr = lane & 15, fq = lane >> 4;
    const bf16_t* z = (const bf16_t*)(p.ws + WS_R1); bf16_t* y = (bf16_t*)(p.ws + WS_R2);
    const float* cw = p.in[I_EVCONV] + (size_t)e * 3 * 512; const float* pscale = p.in[I_EVPOOLS] + (size_t)e * 512;
    const bf16_t* poolT = (const bf16_t*)(p.ws + WS_POOL) + (size_t)e * 4 * 128 * 128;
    float* CV = (float*)lds;
    bf16_t* Zp = (bf16_t*)lds;
    bf16_t* Pl = (bf16_t*)(lds + 40960);
    bf16_t* Bl = (bf16_t*)(lds + 77824);
    u32x4 pa[5], pb[5], pg[4];
    const int NU = 256 * 8, G = gridDim.x;
#define EV_LOAD(uu) do { const int part_ = (uu) & 7, t0_ = ((uu) >> 3) * 128, pos0_ = t0_ & (SEQ - 1); \
        if (part_ < 4) { const int cb_ = part_ * 128; \
            _Pragma("unroll") for (int k = 0; k < 5; ++k) { const int it_ = tid + k * NTHREADS; const int r_ = it_ >> 4, ch_ = it_ & 15; pa[k] = (u32x4){0u, 0u, 0u, 0u}; pb[k] = pa[k]; \
                if (it_ < 130 * 16 && pos0_ + r_ - 2 >= 0) { pa[k] = *(const u32x4*)(z + (size_t)(t0_ + r_ - 2) * EV_N + 512 + cb_ + ch_ * 8); pb[k] = *(const u32x4*)(z + (size_t)(t0_ + r_ - 2) * EV_N + 1024 + cb_ + ch_ * 8); } } \
            _Pragma("unroll") for (int k = 0; k < 4; ++k) { const int it_ = tid + k * NTHREADS; pg[k] = *(const u32x4*)(z + (size_t)(t0_ + (it_ >> 4)) * EV_N + cb_ + (it_ & 15) * 8); } \
        } else { const int cb_ = 1536 + (part_ - 4) * 128; \
            _Pragma("unroll") for (int k = 0; k < 5; ++k) { const int it_ = tid + k * NTHREADS; const int r_ = it_ >> 4, ch_ = it_ & 15; pa[k] = (u32x4){0u, 0u, 0u, 0u}; \
                if (it_ < 143 * 16 && pos0_ + r_ - 15 >= 0) pa[k] = *(const u32x4*)(z + (size_t)(t0_ + r_ - 15) * EV_N + cb_ + ch_ * 8); } } } while (0)
    int gl = -1;
    int u = blockIdx.x;
    if (u < NU) EV_LOAD(u);
    for (; u < NU; u += G) {
        const int part = u & 7, rt = u >> 3; const int t0 = rt * 128; const int pos0 = t0 & (SEQ - 1);
        __syncthreads();
        if (part < 4) {
            const int cbase = part * 128, c0 = cbase + (tid & 15) * 8;
            const f32x4 w0a = *(const f32x4*)(cw + c0), w0b = *(const f32x4*)(cw + c0 + 4), w1a = *(const f32x4*)(cw + 512 + c0), w1b = *(const f32x4*)(cw + 512 + c0 + 4), w2a = *(const f32x4*)(cw + 1024 + c0), w2b = *(const f32x4*)(cw + 1024 + c0 + 4);
#pragma unroll
            for (int k = 0; k < 5; ++k) { const int it = tid + k * NTHREADS; if (it < 130 * 16) { const int r = it >> 4, ch = it & 15; const u32x4 gc = pa[k], vv = pb[k];
                const f32x4 a = {bf_lo(gc[0]) * bf_lo(vv[0]), bf_hi(gc[0]) * bf_hi(vv[0]), bf_lo(gc[1]) * bf_lo(vv[1]), bf_hi(gc[1]) * bf_hi(vv[1])};
                const f32x4 b = {bf_lo(gc[2]) * bf_lo(vv[2]), bf_hi(gc[2]) * bf_hi(vv[2]), bf_lo(gc[3]) * bf_lo(vv[3]), bf_hi(gc[3]) * bf_hi(vv[3])};
                *(f32x4*)(CV + r * 128 + ch * 8) = a; *(f32x4*)(CV + r * 128 + ch * 8 + 4) = b; } }
            u32x4 gb[4];
#pragma unroll
            for (int k = 0; k < 4; ++k) gb[k] = pg[k];
            if (u + G < NU) EV_LOAD(u + G);
            __syncthreads();
#pragma unroll
            for (int k = 0; k < 4; ++k) { const int it = tid + k * NTHREADS; const int r = it >> 4;
                const float* cp = CV + r * 128 + (tid & 15) * 8;
                const f32x4 ca = w0a * *(const f32x4*)(cp) + w1a * *(const f32x4*)(cp + 128) + w2a * *(const f32x4*)(cp + 256);
                const f32x4 cb = w0b * *(const f32x4*)(cp + 4) + w1b * *(const f32x4*)(cp + 132) + w2b * *(const f32x4*)(cp + 260);
                const u32x4 g = gb[k]; u32x4 w;
                w.x = pk2(bf_lo(g[0]) * ca[0], bf_hi(g[0]) * ca[1]); w.y = pk2(bf_lo(g[1]) * ca[2], bf_hi(g[1]) * ca[3]); w.z = pk2(bf_lo(g[2]) * cb[0], bf_hi(g[2]) * cb[1]); w.w = pk2(bf_lo(g[3]) * cb[2], bf_hi(g[3]) * cb[3]);
                *(u32x4*)(y + (size_t)(t0 + r) * DM + c0) = w; }
        } else {
            const int g = part - 4, win = 2 << g;
            if (g != gl) {
                const bf16_t* Bt = poolT + (size_t)g * 128 * 128;
#pragma unroll
                for (int k = 0; k < 4; ++k) { const int it = tid + k * NTHREADS; const int n = it >> 4, ch = it & 15; *(u32x4*)(Bl + n * 136 + ch * 8) = *(const u32x4*)(Bt + (size_t)n * 128 + ch * 8); }
                gl = g; }
            f32x4 sc[8];
#pragma unroll
            for (int nb = 0; nb < 8; ++nb) sc[nb] = *(const f32x4*)(pscale + g * 128 + 16 * nb + 4 * fq);
#pragma unroll
            for (int k = 0; k < 5; ++k) { const int it = tid + k * NTHREADS; if (it < 143 * 16) *(u32x4*)(Zp + (it >> 4) * 128 + (it & 15) * 8) = pa[k]; }
            if (u + G < NU) EV_LOAD(u + G);
            __syncthreads();
#pragma unroll
            for (int k = 0; k < 4; ++k) { const int it = tid + k * NTHREADS; const int r = it >> 4, ch = it & 15; const int pos = pos0 + r;
                float sum[8];
#pragma unroll
                for (int j = 0; j < 8; ++j) sum[j] = 0.f;
                for (int i = 0; i < win; ++i) { const u32x4 v = *(const u32x4*)(Zp + (r + 15 - i) * 128 + ch * 8);
#pragma unroll
                    for (int j = 0; j < 4; ++j) { sum[2 * j] += bf_lo(v[j]); sum[2 * j + 1] += bf_hi(v[j]); } }
                const u32x4 xv = *(const u32x4*)(Zp + (r + 15) * 128 + ch * 8); const float inv = 1.0f / (float)((pos + 1 < win) ? pos + 1 : win);
                u32x4 w;
                w.x = pk2(sum[0] * inv - bf_lo(xv[0]), sum[1] * inv - bf_hi(xv[0])); w.y = pk2(sum[2] * inv - bf_lo(xv[1]), sum[3] * inv - bf_hi(xv[1]));
                w.z = pk2(sum[4] * inv - bf_lo(xv[2]), sum[5] * inv - bf_hi(xv[2])); w.w = pk2(sum[6] * inv - bf_lo(xv[3]), sum[7] * inv - bf_hi(xv[3]));
                *(u32x4*)(Pl + r * 136 + ch * 8) = w; }
            __syncthreads();
            f32x4 acc[8];
#pragma unroll
            for (int nb = 0; nb < 8; ++nb) acc[nb] = (f32x4){0.f, 0.f, 0.f, 0.f};
#pragma unroll
            for (int ks = 0; ks < 4; ++ks) { const bf16x8 a = *(const bf16x8*)(Pl + (16 * wave + fr) * 136 + 32 * ks + 8 * fq);
#pragma unroll
                for (int nb = 0; nb < 8; ++nb) { const bf16x8 b = *(const bf16x8*)(Bl + (16 * nb + fr) * 136 + 32 * ks + 8 * fq); acc[nb] = __builtin_amdgcn_mfma_f32_16x16x32_bf16(b, a, acc[nb], 0, 0, 0); } }
            const int row = rt * 128 + 16 * wave + fr;
#pragma unroll
            for (int nb = 0; nb < 8; ++nb) { const int col = g * 128 + 16 * nb + 4 * fq; const f32x4 o = acc[nb] * sc[nb];
                u32x2 w; w.x = pk2(o[0], o[1]); w.y = pk2(o[2], o[3]); *(u32x2*)(y + (size_t)row * DM + 512 + col) = w; }
        }
    }
#undef EV_LOAD
    __syncthreads();
}

__device__ __forceinline__ void phase_ffnact(const Params& p, int layer, const bf16_t* ug, bf16_t* act, int rows) {
    const float* cw = p.in[I_FFCONVW] + (size_t)layer * 3 * DFF; const float* cb = p.in[I_FFCONVB] + (size_t)layer * DFF;
    constexpr int NCH = DFF / 8, RUN = 16;
    const int nitems = (rows / RUN) * NCH;
    int tid_ = threadIdx.x; asm volatile("" : "+v"(tid_));
    for (int it = blockIdx.x * NTHREADS + tid_; it < nitems; it += gridDim.x * NTHREADS) {
        const int ch = it % NCH, rr = it / NCH; const int c0 = ch * 8; const int t0 = rr * RUN, pos0 = t0 & (SEQ - 1);
        const int ucol = (c0 >> 7) * 256 + (c0 & 127);
        float w0[8], w1[8], w2[8], bb[8];
#pragma unroll
        for (int j = 0; j < 8; ++j) { w0[j] = cw[c0 + j]; w1[j] = cw[DFF + c0 + j]; w2[j] = cw[2 * DFF + c0 + j]; bb[j] = cb[c0 + j]; }
        float u1[8], u2[8];
#pragma unroll
        for (int j = 0; j < 8; ++j) { u1[j] = 0.f; u2[j] = 0.f; }
        if (pos0 >= 2) { const u32x4 a = *(const u32x4*)(ug + (size_t)(t0 - 2) * FF_N + ucol), b = *(const u32x4*)(ug + (size_t)(t0 - 1) * FF_N + ucol);
#pragma unroll
            for (int j = 0; j < 4; ++j) { u2[2 * j] = bf_lo(a[j]); u2[2 * j + 1] = bf_hi(a[j]); u1[2 * j] = bf_lo(b[j]); u1[2 * j + 1] = bf_hi(b[j]); } }
#pragma unroll 4
        for (int i = 0; i < RUN; ++i) { const size_t ro = (size_t)(t0 + i) * FF_N + ucol; const u32x4 uu = *(const u32x4*)(ug + ro), gg = *(const u32x4*)(ug + ro + 128);
            float uc[8], gv[8], o[8];
#pragma unroll
            for (int j = 0; j < 4; ++j) { uc[2 * j] = bf_lo(uu[j]); uc[2 * j + 1] = bf_hi(uu[j]); gv[2 * j] = bf_lo(gg[j]); gv[2 * j + 1] = bf_hi(gg[j]); }
#pragma unroll
            for (int j = 0; j < 8; ++j) { const float a = w0[j] * u2[j] + w1[j] * u1[j] + w2[j] * uc[j] + bb[j]; o[j] = a / (1.f + __expf(-a)) * gv[j]; u2[j] = u1[j]; u1[j] = uc[j]; }
            u32x4 w; w.x = pk2(o[0], o[1]); w.y = pk2(o[2], o[3]); w.z = pk2(o[4], o[5]); w.w = pk2(o[6], o[7]);
            *(u32x4*)(act + (size_t)(t0 + i) * DFF + c0) = w; }
    }
}


__device__ __forceinline__ void ffnfix_pm(const Params& p, int layer, int pm) {
    if ((pm & 15) == 0) return;
    const float* cw = p.in[I_FFCONVW] + (size_t)layer * 3 * DFF;
    const float* UH = (const float*)(p.ws + WS_R2); const float* AP = UH + (size_t)128 * 2 * DFF; const float* GP = AP + (size_t)128 * 2 * DFF;
    bf16_t* act = (bf16_t*)(p.ws + WS_R1);
    int tid_ = threadIdx.x; asm volatile("" : "+v"(tid_));
    constexpr int NCH = DFF / 4;
    for (int it = tid_; it < NCH; it += NTHREADS) {
        const int c0 = it * 4;
        const f32x4 w0 = *(const f32x4*)(cw + c0), w1 = *(const f32x4*)(cw + DFF + c0);
        const f32x4 um2 = *(const f32x4*)(UH + ((size_t)(pm - 1) * 2 + 0) * DFF + c0), um1 = *(const f32x4*)(UH + ((size_t)(pm - 1) * 2 + 1) * DFF + c0);
        const f32x4 a0 = *(const f32x4*)(AP + ((size_t)pm * 2 + 0) * DFF + c0) + w0 * um2 + w1 * um1, a1 = *(const f32x4*)(AP + ((size_t)pm * 2 + 1) * DFF + c0) + w0 * um1;
        const f32x4 g0 = *(const f32x4*)(GP + ((size_t)pm * 2 + 0) * DFF + c0), g1 = *(const f32x4*)(GP + ((size_t)pm * 2 + 1) * DFF + c0);
        f32x4 o0, o1;
#pragma unroll
        for (int c = 0; c < 4; ++c) { o0[c] = a0[c] * __builtin_amdgcn_rcpf(1.f + __builtin_amdgcn_exp2f(a0[c] * -1.4426950408889634f)) * g0[c]; o1[c] = a1[c] * __builtin_amdgcn_rcpf(1.f + __builtin_amdgcn_exp2f(a1[c] * -1.4426950408889634f)) * g1[c]; }
        u32x2 w; w.x = pk2(o0[0], o0[1]); w.y = pk2(o0[2], o0[3]); *(u32x2*)(act + (size_t)(pm * 256) * DFF + c0) = w;
        w.x = pk2(o1[0], o1[1]); w.y = pk2(o1[2], o1[3]); *(u32x2*)(act + (size_t)(pm * 256 + 1) * DFF + c0) = w;
    }
}

__device__ __forceinline__ void phase_scan_kmean(const Params& p, unsigned char* lds) {
    int tid_ = threadIdx.x; asm volatile("" : "+v"(tid_)); const int tid = tid_, lane = tid & 63, wave = tid >> 6;
    const float* lf = (const float*)(p.ws + WS_LF); float* F2 = (float*)(p.ws + WS_F2); float* kmean = (float*)(p.ws + WS_KMEAN);
    const bf16_t* Kg = (const bf16_t*)(p.ws + WS_R1) + (size_t)MROWS * DM;
    float* red = (float*)lds; float* redn = red + 1024;
    float* knt = (float*)(p.ws + WS_KNT);
    const int NU = 64 + 2048, G = gridDim.x; const int ch = tid & 7, rg = tid >> 3;
    u32x4 nk[4];
#define KB_LOAD(uu) do { if ((uu) >= 64 && (uu) < NU) { const int k_ = (uu) - 64; const int blk_ = k_ & 15, h_ = (k_ >> 4) & 15, b_ = k_ >> 8; \
        _Pragma("unroll") for (int i = 0; i < 4; ++i) nk[i] = *(const u32x4*)(Kg + ((size_t)b_ * SEQ + blk_ * 256 + rg * 4 + i) * DM + h_ * 64 + ch * 8); } } while (0)
    int u = blockIdx.x;
    KB_LOAD(u);
    for (; u < NU; u += G) {
        __syncthreads();
        if (u < 64) {
            KB_LOAD(u + G);
            const int b = u >> 3, h = u & 7; float v[8]; float s = 0.f;
#pragma unroll
            for (int i = 0; i < 8; ++i) { s += lf[((size_t)b * SEQ + tid * 8 + i) * 8 + h]; v[i] = s; }
            float incl = s;
#pragma unroll
            for (int o = 1; o < 64; o <<= 1) { const float t = __shfl_up(incl, o); if (lane >= o) incl += t; }
            if (lane == 63) red[wave] = incl;
            __syncthreads();
            float off = incl - s;
            for (int w = 0; w < wave; ++w) off += red[w];
#pragma unroll
            for (int i = 0; i < 8; ++i) F2[((size_t)b * 8 + h) * SEQ + tid * 8 + i] = v[i] + off;
        } else {
            const int k = u - 64; const int blk = k & 15, h = (k >> 4) & 15, b = k >> 8;
            u32x4 ck[4];
#pragma unroll
            for (int i = 0; i < 4; ++i) ck[i] = nk[i];
            KB_LOAD(u + G);
            float s[8], mxn = 0.f;
#pragma unroll
            for (int j = 0; j < 8; ++j) s[j] = 0.f;
#pragma unroll
            for (int i = 0; i < 4; ++i) { float sq = 0.f;
#pragma unroll
                for (int j = 0; j < 4; ++j) { const float a = bf_lo(ck[i][j]), c = bf_hi(ck[i][j]); sq += a * a + c * c; s[2 * j] += a; s[2 * j + 1] += c; }
                sq += __shfl_xor(sq, 1); sq += __shfl_xor(sq, 2); sq += __shfl_xor(sq, 4); mxn = fmaxf(mxn, sq); }
            mxn = fmaxf(mxn, __shfl_xor(mxn, 8)); mxn = fmaxf(mxn, __shfl_xor(mxn, 16)); mxn = fmaxf(mxn, __shfl_xor(mxn, 32));
            if (lane == 0) redn[wave] = mxn;
            if (h >= 8) {
#pragma unroll
                for (int j = 0; j < 8; ++j) { float t = s[j]; t += __shfl_xor(t, 8); t += __shfl_xor(t, 16); t += __shfl_xor(t, 32); s[j] = t; }
                if (lane < 8) {
#pragma unroll
                    for (int j = 0; j < 8; ++j) red[wave * 64 + lane * 8 + j] = s[j]; }
            }
            __syncthreads();
            if (tid < 4) knt[((size_t)b * 16 + h) * 64 + blk * 4 + tid] = fmaxf(redn[2 * tid], redn[2 * tid + 1]);
            if (h >= 8 && tid < 64) { float t = 0.f;
#pragma unroll
                for (int w = 0; w < 8; ++w) t += red[w * 64 + tid];
                kmean[(((size_t)b * 8 + (h - 8)) * 16 + blk) * 64 + tid] = t * (1.0f / 256.0f); }
        }
    }
#undef KB_LOAD
    __syncthreads();
}

constexpr float NEGBIG = -1.0e30f;
template <bool MOBA>
__device__ __forceinline__ void attn_unit(unsigned char* lds, LAS unsigned char* lds3, const Params& p, int b, int h, int qb) {
    int tid_ = threadIdx.x; asm volatile("" : "+v"(tid_)); const int tid = tid_, lane = tid & 63, w = __builtin_amdgcn_readfirstlane(tid >> 6), fr = lane & 15, fq = lane >> 4;
    const bf16_t* Qg = (const bf16_t*)(p.ws + WS_R1); const bf16_t* Kg = Qg + (size_t)MROWS * DM; const bf16_t* Vg = Kg + (size_t)MROWS * DM;
    bf16_t* Og = (bf16_t*)(p.ws + WS_R2);
    const int hcol = (MOBA ? 8 + h : h) * 64; const size_t rowbase = (size_t)b * SEQ;
    LAS bf16_t* Ks = (LAS bf16_t*)lds3; LAS bf16_t* Vt = (LAS bf16_t*)(lds3 + 36864);
    LAS float* Fs = (LAS float*)(lds3 + 73728); LAS float* kms = Fs; LAS float* tbl = (LAS float*)(lds3 + 73728 + 4096); LAS unsigned* sel = (LAS unsigned*)(lds3 + 73728 + 4096 + 512);
    const int NT = 4 * (qb + 1);
    const int skey = tid >> 3, sch = tid & 7;
    const bf16_t* kp = Kg + (rowbase + skey) * DM + hcol + sch * 8; const bf16_t* vp = Vg + (rowbase + skey) * DM + hcol + sch * 8;
    u32x4 kreg[2], vreg[2];
#pragma unroll
    for (int sb = 0; sb < 2; ++sb) { kreg[sb] = *(const u32x4*)(kp + (size_t)(NT - 1 - sb) * 64 * DM); vreg[sb] = *(const u32x4*)(vp + (size_t)(NT - 1 - sb) * 64 * DM); }
    const size_t qrow0 = rowbase + qb * 256 + 32 * w;
    bf16x8 qf[2][2];
#pragma unroll
    for (int jb = 0; jb < 2; ++jb)
#pragma unroll
        for (int ks = 0; ks < 2; ++ks) qf[jb][ks] = *(const bf16x8*)(Qg + (qrow0 + 16 * jb + fr) * DM + hcol + 32 * ks + 8 * fq);
    __syncthreads();
    float c31 = 0.f, bmax = -1.0e30f;
    if (tid < 64) ((LAS float*)(lds3 + 73728 + 16384 + 2048))[64 + tid] = (tid < NT) ? ((const float*)(p.ws + WS_KNT))[((size_t)b * 16 + (MOBA ? 8 + h : h)) * 64 + tid] : 0.f;
    LAS float* kpms = (LAS float*)(lds3 + 73728 + 16384 + 2048);
    volatile LAS unsigned* dflag = (volatile LAS unsigned*)(lds3 + 73728 + 16384 + 2048 + 512);
    if (!MOBA) {
        const float* F2 = (const float*)(p.ws + WS_F2) + ((size_t)b * 8 + h) * SEQ;
        for (int i = tid; i < 256 * (qb + 1); i += NTHREADS) Fs[i] = F2[i];
        if (tid < 16) dflag[tid] = 0u;
    } else {
        const float* km = (const float*)(p.ws + WS_KMEAN) + (((size_t)b * 8 + h) * 16) * 64; const float* relb = p.in[I_RELB];
        for (int i = tid; i < 16 * 64; i += NTHREADS) kms[i] = km[i];
        if (tid < 128) { int bk = tid; if (tid >= 16) { bk = 16 + (int)(logf((float)tid / 16.0f) / 2.0794415416798357f * 16.0f); bk = bk > 31 ? 31 : bk; } tbl[tid] = relb[bk * 8 + h] * LOG2E; }
        c31 = relb[31 * 8 + h] * LOG2E;
        for (int bk = 0; bk < 32; ++bk) bmax = fmaxf(bmax, relb[bk * 8 + h] * LOG2E);
        __syncthreads();
        if (tid < 256) {
            const bf16_t* qp = Qg + (rowbase + qb * 256 + tid) * DM + hcol; float qv[64];
#pragma unroll
            for (int c = 0; c < 8; ++c) { const u32x4 v = *(const u32x4*)(qp + c * 8);
#pragma unroll
                for (int j = 0; j < 4; ++j) { qv[c * 8 + 2 * j] = bf_lo(v[j]); qv[c * 8 + 2 * j + 1] = bf_hi(v[j]); } }
            float v1 = -INFINITY, v2 = -INFINITY, v3 = -INFINITY; int i1 = -1, i2 = -1, i3 = -1;
            for (int j = 0; j < qb; ++j) { float d = 0.f;
#pragma unroll
                for (int c = 0; c < 16; ++c) { const f32x4 kv = *(const LAS f32x4*)(kms + j * 64 + c * 4); d += qv[4 * c] * kv[0] + qv[4 * c + 1] * kv[1] + qv[4 * c + 2] * kv[2] + qv[4 * c + 3] * kv[3]; }
                if (d > v1) { v3 = v2; i3 = i2; v2 = v1; i2 = i1; v1 = d; i1 = j; } else if (d > v2) { v3 = v2; i3 = i2; v2 = d; i2 = j; } else if (d > v3) { v3 = d; i3 = j; } }
            unsigned mask = 0u; if (i1 >= 0) mask |= 1u << i1; if (i2 >= 0) mask |= 1u << i2; if (i3 >= 0) mask |= 1u << i3;
            sel[tid] = mask | (1u << qb);
        }
    }
    const int vswz = (skey ^ (sch << 3));
#define ATT_STORE1(slot, kreg, vreg) do { *(LAS u32x4*)(Ks + (slot) * 4608 + skey * 72 + sch * 8) = kreg; \
        _Pragma("unroll") for (int i_ = 0; i_ < 4; ++i_) { Vt[(slot) * 4608 + (sch * 8 + 2 * i_) * 72 + vswz] = (bf16_t)(vreg[i_] & 0xffffu); Vt[(slot) * 4608 + (sch * 8 + 2 * i_ + 1) * 72 + vswz] = (bf16_t)(vreg[i_] >> 16); } } while (0)
#define ATT_STORE(buf) do { ATT_STORE1((buf) * 2, kreg[0], vreg[0]); ATT_STORE1((buf) * 2 + 1, kreg[1], vreg[1]); } while (0)
    ATT_STORE(0);
    __syncthreads();
    if (tid < 64) { float pm = 0.f; for (int t = 0; t <= tid; ++t) pm = fmaxf(pm, kpms[64 + t]); kpms[tid] = sqrtf(pm) * 1.002f; }
    __syncthreads();
    f32x4 o[4][2];
#pragma unroll
    for (int db = 0; db < 4; ++db) { o[db][0] = (f32x4){0.f, 0.f, 0.f, 0.f}; o[db][1] = (f32x4){0.f, 0.f, 0.f, 0.f}; }
    float lrow[2] = {0.f, 0.f};
    float fq2[2] = {0.f, 0.f}; unsigned selm[2] = {0u, 0u};
    if (!MOBA) { fq2[0] = Fs[qb * 256 + 32 * w + fr]; fq2[1] = Fs[qb * 256 + 32 * w + 16 + fr]; }
    else { selm[0] = sel[32 * w + fr]; selm[1] = sel[32 * w + 16 + fr]; }
    const int qloc = 32 * w + fr;
    float mref[2], fq0 = 0.f; bool wdone = false;
    {
        float sq[2] = {0.f, 0.f};
#pragma unroll
        for (int jb = 0; jb < 2; ++jb)
#pragma unroll
            for (int ks = 0; ks < 2; ++ks) { const u32x4 qv = __builtin_bit_cast(u32x4, qf[jb][ks]);
#pragma unroll
                for (int j = 0; j < 4; ++j) { const float a = bf_lo(qv[j]), c = bf_hi(qv[j]); sq[jb] += a * a + c * c; } }
        const float kall = kpms[NT - 1];
#pragma unroll
        for (int jb = 0; jb < 2; ++jb) { float v = sq[jb]; v += __shfl_xor(v, 16); v += __shfl_xor(v, 32); mref[jb] = sqrtf(v) * 1.002f * kall + (MOBA ? bmax : 0.f); }
        if (!MOBA) fq0 = Fs[qb * 256 + 32 * w];
    }
    LAS unsigned char* listq = (LAS unsigned char*)(lds3 + 80000); LAS unsigned char* cntw = (LAS unsigned char*)(lds3 + 85120); LAS int* njs = (LAS int*)(lds3 + 85248); LAS float* mrefs = (LAS float*)(lds3 + 84096); LAS float* pst = (LAS float*)(lds3 + 93184);
    int qpl[2] = {qloc, qloc + 16}; bool qv[2] = {true, true}; float mrc[2] = {mref[0], mref[1]};
    if (MOBA) {
        for (int i = tid; i < 256 * 68; i += NTHREADS) pst[i] = 0.f;
        if (fq == 0) { mrefs[32 * w + fr] = mref[0]; mrefs[32 * w + 16 + fr] = mref[1]; }
        const unsigned my = sel[32 * w + (lane & 31)];
        for (int j = 0; j < qb; ++j) { const bool bit = (lane < 32) && ((my >> j) & 1u); const unsigned M = (unsigned)__ballot(bit); if (lane == 0) cntw[w * 16 + j] = (unsigned char)__builtin_popcount(M); }
        __syncthreads();
        for (int j = 0; j < qb; ++j) { const bool bit = (lane < 32) && ((my >> j) & 1u); const unsigned M = (unsigned)__ballot(bit);
            int base = 0, tot = 0;
#pragma unroll
            for (int w2 = 0; w2 < 8; ++w2) { const int c = cntw[w2 * 16 + j]; if (w2 < w) base += c; tot += c; }
            if (bit) listq[j * 256 + base + __builtin_popcount(M & ((1u << (lane & 31)) - 1u))] = (unsigned char)(32 * w + (lane & 31));
            if (tid == 0) njs[j] = tot; }
        __syncthreads();
    }
    bf16x8 qn[2][2] = {{qf[0][0], qf[0][1]}, {qf[1][0], qf[1][1]}};
#define ATT_QPREF(jj) do { if (MOBA && (jj) >= 0) { const int nj_ = __builtin_amdgcn_readfirstlane(njs[jj]); if (32 * w < nj_) { \
        _Pragma("unroll") for (int jb = 0; jb < 2; ++jb) { const int slot_ = 32 * w + 16 * jb + fr; const int q_ = (slot_ < nj_) ? (int)listq[(jj) * 256 + slot_] : 0; \
            _Pragma("unroll") for (int ks = 0; ks < 2; ++ks) qn[jb][ks] = *(const bf16x8*)(Qg + (rowbase + qb * 256 + q_) * DM + hcol + 32 * ks + 8 * fq); } } } } while (0)
    for (int st = 0; st < NT / 2; ++st) {
        const int buf = st & 1;
        if (st + 1 < NT / 2) {
#pragma unroll
            for (int sb = 0; sb < 2; ++sb) { const size_t o_ = (size_t)(NT - 1 - (2 * st + 2 + sb)) * 64 * DM; kreg[sb] = *(const u32x4*)(kp + o_); vreg[sb] = *(const u32x4*)(vp + o_); } }
      for (int sub = 0; sub < 2; ++sub) {
        const int it = 2 * st + sub, t = NT - 1 - it, slot = buf * 2 + sub;
        const int tl = t - 4 * qb;
        if (!MOBA && !wdone && (fq0 - Fs[64 * t + 63]) < -136.f) wdone = true;
        bool active = (tl <= (w >> 1)) && !wdone;
        if (MOBA && it == 0) ATT_QPREF(qb - 1);
        if (MOBA && tl < 0) {
            const int j = t >> 2; const int nj = __builtin_amdgcn_readfirstlane(njs[j]);
            active = (32 * w < nj);
            if (active && (t & 3) == 3) {
#pragma unroll
                for (int jb = 0; jb < 2; ++jb) { const int slot = 32 * w + 16 * jb + fr; qv[jb] = slot < nj; const int q = qv[jb] ? (int)listq[j * 256 + slot] : 0; qpl[jb] = q; mrc[jb] = mrefs[q];
#pragma unroll
                    for (int ks = 0; ks < 2; ++ks) qf[jb][ks] = qn[jb][ks]; }
            }
            if ((t & 3) == 3) ATT_QPREF(j - 1);
        }
        if (active) {
            const bool diag = (tl == (w >> 1));
            f32x4 s[4][2];
            bool band = false;
            if (!MOBA) {
                const float f0 = fq2[0] - mref[0], f1 = fq2[1] - mref[1];
#pragma unroll
                for (int kb = 0; kb < 4; ++kb) { const f32x4 fk = *(const LAS f32x4*)(Fs + 64 * t + 16 * kb + 4 * fq); s[kb][0] = f0 - fk; s[kb][1] = f1 - fk; }
            } else {
                band = (t >> 2) >= qb - 1;
                const float cc = band ? 0.f : c31;
                const float c0 = (qv[0] ? cc : NEGBIG) - mrc[0], c1 = (qv[1] ? cc : NEGBIG) - mrc[1];
#pragma unroll
                for (int kb = 0; kb < 4; ++kb) { s[kb][0] = (f32x4){c0, c0, c0, c0}; s[kb][1] = (f32x4){c1, c1, c1, c1}; }
            }
            { bf16x8 kf[4][2];
#pragma unroll
            for (int kb = 0; kb < 4; ++kb)
#pragma unroll
                for (int ks = 0; ks < 2; ++ks) kf[kb][ks] = *(const LAS bf16x8*)(Ks + slot * 4608 + (16 * kb + fr) * 72 + 32 * ks + 8 * fq);
            __builtin_amdgcn_sched_barrier(0);
#pragma unroll
            for (int kb = 0; kb < 4; ++kb)
#pragma unroll
                for (int ks = 0; ks < 2; ++ks) {
                    s[kb][0] = __builtin_amdgcn_mfma_f32_16x16x32_bf16(kf[kb][ks], qf[0][ks], s[kb][0], 0, 0, 0); s[kb][1] = __builtin_amdgcn_mfma_f32_16x16x32_bf16(kf[kb][ks], qf[1][ks], s[kb][1], 0, 0, 0); }
            __builtin_amdgcn_sched_barrier(0); }
            if (MOBA && band) {
                asm volatile("" ::: "memory");
#pragma unroll
                for (int kb = 0; kb < 4; ++kb)
#pragma unroll
                    for (int jb = 0; jb < 2; ++jb)
#pragma unroll
                        for (int r = 0; r < 4; ++r) { int d = (256 * qb + qpl[jb]) - (64 * t + 16 * kb + 4 * fq + r); d = d < 0 ? 0 : (d > 127 ? 127 : d); s[kb][jb][r] += tbl[d]; }
            }
            if (diag) {
                asm volatile("" ::: "memory");
#pragma unroll
                for (int kb = 0; kb < 4; ++kb)
#pragma unroll
                    for (int jb = 0; jb < 2; ++jb)
#pragma unroll
                        for (int r = 0; r < 4; ++r) { if ((64 * tl + 16 * kb + 4 * fq + r) > (MOBA ? qpl[jb] : qloc + 16 * jb)) s[kb][jb][r] = NEGBIG; }
            }
            {
#pragma unroll
            for (int jb = 0; jb < 2; ++jb) { float ls = 0.f;
#pragma unroll
                for (int kb = 0; kb < 4; ++kb)
#pragma unroll
                    for (int r = 0; r < 4; ++r) { const float e = __builtin_amdgcn_exp2f(s[kb][jb][r]); s[kb][jb][r] = e; ls += e; }
                lrow[jb] += ls; }
            { u32x2 vlo[2][4], vhi[2][4];
#pragma unroll
            for (int ks2 = 0; ks2 < 2; ++ks2)
#pragma unroll
                for (int db = 0; db < 4; ++db) { const int d = 32 * (db >> 1) + 8 * (fr >> 2) + 4 * (db & 1) + (fr & 3);        const int kx = (32 * ks2 + 4 * fq) ^ (((d >> 3) & 7) << 3);
                    vlo[ks2][db] = *(const LAS u32x2*)(Vt + slot * 4608 + d * 72 + kx); vhi[ks2][db] = *(const LAS u32x2*)(Vt + slot * 4608 + d * 72 + (kx ^ 16)); }
            bf16x8 pf[2][2];
#pragma unroll
            for (int ks2 = 0; ks2 < 2; ++ks2)
#pragma unroll
                for (int jb = 0; jb < 2; ++jb) { const f32x4 a = s[2 * ks2][jb], c = s[2 * ks2 + 1][jb]; u32x4 pw; pw.x = pk2(a[0], a[1]); pw.y = pk2(a[2], a[3]); pw.z = pk2(c[0], c[1]); pw.w = pk2(c[2], c[3]); pf[ks2][jb] = __builtin_bit_cast(bf16x8, pw); }
            __builtin_amdgcn_sched_barrier(0);
#pragma unroll
            for (int ks2 = 0; ks2 < 2; ++ks2)
#pragma unroll
                for (int db = 0; db < 4; ++db) { u32x4 vv; vv.x = vlo[ks2][db].x; vv.y = vlo[ks2][db].y; vv.z = vhi[ks2][db].x; vv.w = vhi[ks2][db].y; const bf16x8 vf = __builtin_bit_cast(bf16x8, vv);
                    o[db][0] = __builtin_amdgcn_mfma_f32_16x16x32_bf16(vf, pf[ks2][0], o[db][0], 0, 0, 0); o[db][1] = __builtin_amdgcn_mfma_f32_16x16x32_bf16(vf, pf[ks2][1], o[db][1], 0, 0, 0); }
            __builtin_amdgcn_sched_barrier(0); }
            }
        }
        if (MOBA && (t & 3) == 0 && (tl >= 0 || active)) {
#pragma unroll
            for (int jb = 0; jb < 2; ++jb) { float l = lrow[jb]; l += __shfl_xor(l, 16); l += __shfl_xor(l, 32);
                if (qv[jb]) { LAS float* st = pst + qpl[jb] * 68;
#pragma unroll
                    for (int db = 0; db < 4; ++db) { f32x4 ov = o[db][jb]; asm volatile("" : "+v"(ov)); f32x4 v = *(const LAS f32x4*)(st + 32 * (db >> 1) + 8 * fq + 4 * (db & 1)); v += ov; *(LAS f32x4*)(st + 32 * (db >> 1) + 8 * fq + 4 * (db & 1)) = v; }
                    if (fq == 0) st[64] += l; }
#pragma unroll
                for (int db = 0; db < 4; ++db) o[db][jb] = (f32x4){0.f, 0.f, 0.f, 0.f};
                lrow[jb] = 0.f; }
        }
      }
        if (st + 1 < NT / 2) ATT_STORE(buf ^ 1);
        if (!MOBA) { if (lane == 0) dflag[(st & 1) * 8 + w] = wdone ? 1u : 0u; }
        __syncthreads();
        if (!MOBA) { const u32x4 fa = *(const LAS u32x4*)(lds3 + 73728 + 16384 + 2048 + 512 + (st & 1) * 32), fb = *(const LAS u32x4*)(lds3 + 73728 + 16384 + 2048 + 512 + (st & 1) * 32 + 16);
            if ((fa[0] & fa[1] & fa[2] & fa[3] & fb[0] & fb[1] & fb[2] & fb[3]) != 0u) break; }
    }
#undef ATT_STORE
#undef ATT_STORE1
#undef ATT_QPREF
#pragma unroll
    for (int jb = 0; jb < 2; ++jb) { float l = lrow[jb]; l += __shfl_xor(l, 16); l += __shfl_xor(l, 32);
        if (MOBA) { const LAS float* st = pst + (qloc + 16 * jb) * 68; l = st[64];
#pragma unroll
            for (int db = 0; db < 4; ++db) o[db][jb] = *(const LAS f32x4*)(st + 32 * (db >> 1) + 8 * fq + 4 * (db & 1)); }
        const float inv = 1.0f / l;
        bf16_t* op = Og + (qrow0 + 16 * jb + fr) * DM + hcol + 8 * fq;
#pragma unroll
        for (int dp = 0; dp < 2; ++dp) { const f32x4 v0 = o[2 * dp][jb] * inv, v1 = o[2 * dp + 1][jb] * inv; u32x4 wv; wv.x = pk2(v0[0], v0[1]); wv.y = pk2(v0[2], v0[3]); wv.z = pk2(v1[0], v1[1]); wv.w = pk2(v1[2], v1[3]); *(u32x4*)(op + 32 * dp) = wv; } }
}
__device__ __forceinline__ void phase_attn(const Params& p, unsigned char* lds, LAS unsigned char* lds3) {
    for (int u = blockIdx.x; u < 2048; u += gridDim.x) {
        const int bx = u & 255, i = u >> 8; const int wv = (bx & 7) * 32 + (bx >> 3);
        const int combo = wv >> 2, quarter = wv & 3; const int k = i & 3;
        const int b = combo >> 3, h = ((combo & 7) + 2 * k + (i >> 2)) & 7;
        const int qb = (k == 0) ? quarter : (k == 1) ? 15 - quarter : (k == 2) ? 7 - quarter : 8 + quarter;
        if (i < 4) attn_unit<true>(lds, lds3, p, b, h, qb); else attn_unit<false>(lds, lds3, p, b, h, qb);
    }
    __syncthreads();
}

__device__ __forceinline__ void phase_final(const Params& p) {
    int tid_ = threadIdx.x; asm volatile("" : "+v"(tid_)); const int tid = tid_, lane = tid & 63, wave = tid >> 6;
    const int gw = blockIdx.x * NWAVES + wave, NGW = gridDim.x * NWAVES;
    const float* ssq = (const float*)(p.ws + WS_SSQ); const float* g = p.in[I_FING]; float* out = p.out;
    f32x4 gv[4];
#pragma unroll
    for (int j = 0; j < 4; ++j) gv[j] = ((const f32x4*)g)[lane + 64 * j];
    const bf16_t* hb = (const bf16_t*)(p.ws + WS_HB);
    u32x2 nh[4]; f32x4 ns = {0.f, 0.f, 0.f, 0.f};
    if (gw < MROWS) { const u32x2* hr = (const u32x2*)(hb + (size_t)gw * DM) + lane; ns = *(const f32x4*)(ssq + (size_t)gw * 4);
#pragma unroll
        for (int j = 0; j < 4; ++j) nh[j] = hr[64 * j]; }
    for (int m = gw; m < MROWS; m += NGW) {
        u32x2 ch[4]; const f32x4 cs = ns;
#pragma unroll
        for (int j = 0; j < 4; ++j) ch[j] = nh[j];
        if (m + NGW < MROWS) { const u32x2* hr = (const u32x2*)(hb + (size_t)(m + NGW) * DM) + lane; ns = *(const f32x4*)(ssq + (size_t)(m + NGW) * 4);
#pragma unroll
            for (int j = 0; j < 4; ++j) nh[j] = hr[64 * j]; }
        const float rs = __builtin_amdgcn_rsqf(((cs[0] + cs[1]) + (cs[2] + cs[3])) * (1.0f / 1024.0f) + 1e-6f); f32x4* xr = (f32x4*)(out + (size_t)m * DM) + lane;
#pragma unroll
        for (int j = 0; j < 4; ++j) { const u32x2 hv = ch[j]; const f32x4 v = {bf_lo(hv.x), bf_hi(hv.x), bf_lo(hv.y), bf_hi(hv.y)}; xr[64 * j] = v * rs * gv[j]; } }
}

#define XB_TMO      128
#define XB_XCNT(j)  (256  + 64 * (j))
#define XB_XSUB(j)  (1280 + 64 * (j))
#define XB_XGEN(j)  (2304 + 64 * (j))
#define XB_TOP      3328
#define XB_TOPGEN   3392
#define XCD_BAR_WORDS 3456
#define XB_SPIN_CAP (1u << 18)

__device__ __forceinline__ unsigned xb_ld(unsigned* p)              { return __hip_atomic_load(p, __ATOMIC_RELAXED, __HIP_MEMORY_SCOPE_AGENT); }
__device__ __forceinline__ unsigned xb_add(unsigned* p, unsigned v) { return __hip_atomic_fetch_add(p, v, __ATOMIC_RELAXED, __HIP_MEMORY_SCOPE_AGENT); }
__device__ __forceinline__ unsigned xb_xcc_id() { return (unsigned)__builtin_amdgcn_s_getreg((3 << 11) | 20) & 0xFu; }
#define XB_SPIN(cond, bar) do { unsigned _sp = 0; while (cond) { __builtin_amdgcn_s_sleep(1); \
    if ((++_sp & 255u) == 0u) { if (xb_ld(&(bar)[XB_TMO])) break; if (_sp > XB_SPIN_CAP) { atomicAdd(&(bar)[XB_TMO], 1u); break; } } } } while (0)

struct XcdBarrier {
    unsigned* bar; unsigned x;
    volatile LAS unsigned* st;
};

__device__ __forceinline__ XcdBarrier xcd_barrier_post(unsigned* bar, volatile LAS unsigned* st) {
    XcdBarrier b; b.bar = bar; b.x = xb_xcc_id(); b.st = st;
    if (threadIdx.x == 0) (void)xb_add(&bar[XB_XCNT(b.x)], 1u);
    return b;
}
__device__ __forceinline__ void xcd_barrier_complete(unsigned* bar, unsigned x, unsigned& nloc, unsigned& nx) {
    const unsigned G = gridDim.x * gridDim.y * gridDim.z;
    unsigned sum, cnt, mine, sp = 0u;
    for (;;) {
        sum = 0u; cnt = 0u; mine = 0u;
#pragma unroll
        for (unsigned j = 0; j < 16; ++j) { const unsigned c = xb_ld(&bar[XB_XCNT(j)]); sum += c; cnt += (c > 0u) ? 1u : 0u; mine = (j == x) ? c : mine; }
        if (sum == G) break;
        __builtin_amdgcn_s_sleep(1);
        if ((++sp & 255u) == 0u) { if (xb_ld(&bar[XB_TMO])) break; if (sp > XB_SPIN_CAP) { atomicAdd(&bar[XB_TMO], 1u); break; } }
    }
    nloc = mine > 0u ? mine : 1u; nx = cnt > 0u ? cnt : 1u;
}

__device__ __forceinline__ void xcd_barrier(const XcdBarrier& b) {
    asm volatile("s_waitcnt vmcnt(0)" ::: "memory");
    __syncthreads();
    if (threadIdx.x == 0) {
        unsigned* bar = b.bar;
        __builtin_amdgcn_s_waitcnt(0);
        unsigned nloc = b.st[0], nx = b.st[1];
        if (nloc == 0u) { xcd_barrier_complete(bar, b.x, nloc, nx); b.st[0] = nloc; b.st[1] = nx; }
        const unsigned old = xb_add(&bar[XB_XSUB(b.x)], 1u);
        const unsigned gen = old / nloc;
        if (old + 1u == (gen + 1u) * nloc) {
            __builtin_amdgcn_fence(__ATOMIC_RELEASE, "agent");
            asm volatile("s_waitcnt vmcnt(0)" ::: "memory");
            const unsigned og = xb_add(&bar[XB_TOP], 1u);
            const unsigned tg = og / nx;
            if (og + 1u == (tg + 1u) * nx) xb_add(&bar[XB_TOPGEN], 1u);
            else XB_SPIN(xb_ld(&bar[XB_TOPGEN]) == tg, bar);
            __builtin_amdgcn_fence(__ATOMIC_ACQUIRE, "agent");
            xb_add(&bar[XB_XGEN(b.x)], 1u);
            asm volatile("s_waitcnt vmcnt(0)" ::: "memory");
        } else {
            XB_SPIN(xb_ld(&bar[XB_XGEN(b.x)]) == gen, bar);
            __builtin_amdgcn_fence(__ATOMIC_ACQUIRE, "agent");
            asm volatile("s_waitcnt vmcnt(0)" ::: "memory");
        }
    }
    __syncthreads();
}

constexpr size_t WS_BAR = 100 * MiB + 512 * 1024;
typedef const Params __attribute__((address_space(4)))* KPtr;
__device__ __forceinline__ Params load_params(KPtr kp) { Params p;
#pragma unroll
    for (int i = 0; i < 17; ++i) p.in[i] = kp->in[i];
    p.out = kp->out; p.ws = kp->ws; p.ph_lo = kp->ph_lo; p.ph_hi = kp->ph_hi; return p; }
__global__ void __launch_bounds__(NTHREADS, 2) fwd_megakernel(Params p_arg) {
    extern __shared__ __attribute__((aligned(16))) unsigned char lds[];
    cg::grid_group grid = cg::this_grid();
    PG8_LAS unsigned char* lds3 = (PG8_LAS unsigned char*)lds;
    const KPtr kp0 = (KPtr)__builtin_amdgcn_kernarg_segment_ptr();
    const int ph_lo = p_arg.ph_lo, ph_hi = p_arg.ph_hi;
    volatile LAS unsigned* bst = (volatile LAS unsigned*)(lds3 + 163776);
    if (threadIdx.x < 2) bst[threadIdx.x] = 0u;
    __syncthreads();
    XcdBarrier xbar; xbar.bar = nullptr; xbar.x = 0; xbar.st = bst;
    int ph = 0;
#define PH_BEGIN if (ph >= ph_lo && ph < ph_hi) { KPtr kp_ = kp0; asm volatile("" : "+s"(kp_)); const Params p = load_params(kp_); unsigned char* ws = p.ws; \
    bf16_t* hb = (bf16_t*)(ws + WS_HB); float* ssq = (float*)(ws + WS_SSQ); bf16_t* R1 = (bf16_t*)(ws + WS_R1); bf16_t* R2 = (bf16_t*)(ws + WS_R2); (void)hb; (void)ssq; (void)R1; (void)R2;
#define PH_END_LOCAL asm volatile("s_waitcnt vmcnt(0)" ::: "memory"); __syncthreads(); }
#define PH_END   if (ph + 1 < ph_hi) { if (ph == 0) { grid.sync(); xbar = xcd_barrier_post((unsigned*)(ws + WS_BAR), bst); } else xcd_barrier(xbar); } } ++ph;
    PH_BEGIN { if (blockIdx.x == 0) { unsigned* bw = (unsigned*)(ws + WS_BAR); for (int i = threadIdx.x; i < XCD_BAR_WORDS; i += NTHREADS) bw[i] = 0u; } phase_prologue(p, lds); } PH_END
    for (int layer = 0; layer < 4; ++layer) {
        const int e = layer >> 1;
        if ((layer & 1) == 0) {
            PH_BEGIN { pg8::Gemm g{hb, (const bf16_t*)(ws + WS_EVIN) + (size_t)e * EV_N * DM, MROWS, EV_N, DM}; pg8::StaticOrder S; S.init(MROWS, EV_N, gridDim.x, blockIdx.x);
                pg8::EpiScaleBf16 E{R1, EV_N, ssq, 0, 0, 0, 1.f, -1, nullptr, nullptr};
                pg8::gemm_phase<pg8::EpiScaleBf16, pg8::StaticOrder, true, true>(lds3, g, S, E); } PH_END
            PH_BEGIN phase_evmix(p, lds, e); PH_END
            PH_BEGIN { pg8::Gemm g{R2, (const bf16_t*)(ws + WS_EVOUT) + (size_t)e * DM * DM, MROWS, DM, DM}; pg8::StaticOrder S; S.init(MROWS, DM, gridDim.x, blockIdx.x);
                pg8::EpiResid E{(layer == 0) ? p.in[I_X] : nullptr, hb, ssq, 0, (PG8_LAS float*)(lds3 + 131072)};
                pg8::gemm_phase<pg8::EpiResid, pg8::StaticOrder, true, true>(lds3, g, S, E); } PH_END
        } else {
            PH_BEGIN { pg8::Gemm g{hb, (const bf16_t*)(ws + WS_ODIN) + (size_t)e * OD_NP * DM, MROWS, OD_NP, DM}; pg8::StaticOrder S; S.init(MROWS, OD_NP, gridDim.x, blockIdx.x);
                pg8::EpiScaleBf16 E{R1, DM, ssq, 0, DM, (size_t)MROWS * DM, 0.125f * LOG2E, 12, (float*)(ws + WS_LF), p.in[I_ODBF] + e * 8};
                pg8::gemm_phase<pg8::EpiScaleBf16, pg8::StaticOrder, true, true>(lds3, g, S, E); } PH_END
            PH_BEGIN phase_scan_kmean(p, lds); PH_END
            PH_BEGIN phase_attn(p, lds, lds3); PH_END
            PH_BEGIN { pg8::Gemm g{R2, (const bf16_t*)(ws + WS_ODOUT) + (size_t)e * DM * DM, MROWS, DM, DM}; pg8::StaticOrder S; S.init(MROWS, DM, gridDim.x, blockIdx.x);
                pg8::EpiResid E{(layer == 0) ? p.in[I_X] : nullptr, hb, ssq, 0, (PG8_LAS float*)(lds3 + 131072)};
                pg8::gemm_phase<pg8::EpiResid, pg8::StaticOrder, true, true>(lds3, g, S, E); } PH_END
        }
        PH_BEGIN { pg8::Gemm g{hb, (const bf16_t*)(ws + WS_FFIN) + (size_t)layer * FF_N * DM, MROWS, FF_N, DM}; pg8::StaticOrder S; S.init(MROWS, FF_N, gridDim.x, blockIdx.x);
            float* UH = (float*)(ws + WS_R2);
            pg8::EpiFfnAct E{R1, ssq, p.in[I_FFCONVW] + (size_t)layer * 3 * DFF, p.in[I_FFCONVB] + (size_t)layer * DFF, UH, UH + (size_t)128 * 2 * DFF, UH + (size_t)2 * 128 * 2 * DFF, (PG8_LAS float*)(lds3 + 131072)};
            pg8::gemm_phase<pg8::EpiFfnAct, pg8::StaticOrder, true, true>(lds3, g, S, E); } PH_END
        PH_BEGIN { pg8::StaticOrder S; S.init(MROWS, DM, gridDim.x, blockIdx.x); pg8::Unit fu; int lastpm = -1;
            for (int i = 0; S.next(i, fu); ++i) { if (fu.pm != lastpm) ffnfix_pm(p, layer, fu.pm); lastpm = fu.pm; } } PH_END_LOCAL
        PH_BEGIN { pg8::Gemm g{R1, (const bf16_t*)(ws + WS_FFOUT) + (size_t)layer * DM * DFF, MROWS, DM, DFF}; pg8::StaticOrder S; S.init(MROWS, DM, gridDim.x, blockIdx.x);
            pg8::EpiResid E{nullptr, hb, ssq, 0, (PG8_LAS float*)(lds3 + 131072)};
            pg8::gemm_phase<pg8::EpiResid, pg8::StaticOrder, true, true>(lds3, g, S, E); } PH_END
    }
    PH_BEGIN phase_final(p); PH_END
}
constexpr int N_PHASES = 1 + 2 * (3 + 2) + 2 * (4 + 2) + 1;

#ifndef ONE_LAUNCH
#define ONE_LAUNCH 1
#endif
extern "C" void kernel_launch(void* const* d_in, const int* in_sizes, int n_in, void* d_out, int out_size, void* d_ws, size_t ws_size, hipStream_t stream) {
    static int grid = 0;
    if (grid == 0) {
        if (n_in != 17 || out_size != MROWS * DM || ws_size < WS_END) { fprintf(stderr, "kernel_launch: unexpected shapes (n_in %d out %d ws %zu)\n", n_in, out_size, ws_size); grid = -1; return; }
        int dev = 0, cus = 0, per_cu = 0;
        hipGetDevice(&dev); hipDeviceGetAttribute(&cus, hipDeviceAttributeMultiprocessorCount, dev);
        hipFuncSetAttribute((const void*)fwd_megakernel, hipFuncAttributeMaxDynamicSharedMemorySize, LDS_BYTES);
        hipOccupancyMaxActiveBlocksPerMultiprocessor(&per_cu, (const void*)fwd_megakernel, NTHREADS, LDS_BYTES);
        if (per_cu < 1) { fprintf(stderr, "kernel_launch: occupancy query says %d blocks per CU\n", per_cu); per_cu = 1; }
        (void)hipGetLastError();
        grid = cus;
    }
    if (grid < 0) return;
    Params p{};
    for (int i = 0; i < 17; ++i) p.in[i] = (const float*)d_in[i];
    p.out = (float*)d_out; p.ws = (unsigned char*)d_ws;
#if ONE_LAUNCH
    p.ph_lo = 0; p.ph_hi = N_PHASES;
    void* args[] = {&p};
    hipError_t e = hipLaunchCooperativeKernel((const void*)fwd_megakernel, dim3(grid), dim3(NTHREADS), args, LDS_BYTES, stream);
    if (e != hipSuccess) fprintf(stderr, "cooperative launch failed: %s (grid %d)\n", hipGetErrorString(e), grid);
#else
    for (int ph = 0; ph < N_PHASES; ++ph) { p.ph_lo = ph; p.ph_hi = ph + 1; hipLaunchKernelGGL(fwd_megakernel, dim3(grid), dim3(NTHREADS), LDS_BYTES, stream, p); }
#endif
}
```

```cpp
#include <hip/hip_runtime.h>
#include <hip/hip_cooperative_groups.h>
#include <cstdio>
#include <cstdint>
namespace cg = cooperative_groups;
namespace pg8 {
#define PG8_LAS __attribute__((address_space(3)))
typedef unsigned short bf16_t;
typedef short bf16x8 __attribute__((ext_vector_type(8)));
typedef float f32x4 __attribute__((ext_vector_type(4)));
typedef unsigned u32x4 __attribute__((ext_vector_type(4)));
constexpr int BM = 256, BK = 64, HALF = 128, HTB = HALF * BK * 2  , STAGE_BYTES = 8 * HTB, NXCD = 8, WGM = 8;

__host__ __device__ __forceinline__ int lds_byte(int r, int c) { const int st = (r >> 4) * 2 + (c >> 5), rr = r & 15, cc = c & 31, ob = rr * 64 + cc * 2; return st * 1024 + (ob ^ (((ob >> 9) & 1) << 5)); }
__host__ __device__ __forceinline__ void stage_rc(int b, int& R, int& C) { const int st = b / 1024, sb = b % 1024, swz = sb ^ (((sb >> 9) & 1) << 5); R = (st >> 1) * 16 + swz / 64; C = (st & 1) * 32 + (swz % 64) / 2; }
__host__ __device__ __forceinline__ int perm32(int rho) { const int n = rho >> 4, i = rho & 15; return 8 * (i >> 2) + 4 * n + (i & 3); }

struct Unit { int pm, pn; };
struct Gemm { const bf16_t* A; const bf16_t* Bt; int M, N, K; };

struct StaticOrder {
    int nM, nN, nwg, G, c;
    __host__ __device__ __forceinline__ void init(int M, int N, int G_, int c_) { nM = M / BM; nN = N / BM; nwg = nM * nN; G = G_; c = c_; }
    __host__ __device__ __forceinline__ bool next(int i, Unit& u) const {
        const long L = (long)i * G + c; if (L >= nwg) return false;
        int wgid = (int)L; { const int q = nwg / NXCD, r = nwg % NXCD, xcd = wgid % NXCD, off = wgid / NXCD; wgid = (xcd < r ? xcd * (q + 1) : r * (q + 1) + (xcd - r) * q) + off; }
        const int nig = WGM * nN, gid = wgid / nig, fm = gid * WGM, gsz = (nM - fm) < WGM ? (nM - fm) : WGM;
        u.pm = fm + ((wgid % nig) % gsz); u.pn = (wgid % nig) / gsz; return true;
    }
    __device__ __forceinline__ void a_ready(const Unit&) const {}
    __device__ __forceinline__ void done(const Unit&) const {}
};

__device__ __forceinline__ unsigned cvt_pk_bf16(float lo, float hi) { unsigned r; asm volatile("v_cvt_pk_bf16_f32 %0, %1, %2" : "=v"(r) : "v"(lo), "v"(hi)); return r; }
#ifdef TEST_NORSTD
#define TEST_RS(x) 1.0f
#else
#define TEST_RS(x) (x)
#endif
typedef unsigned u32x2 __attribute__((ext_vector_type(2)));
__device__ __forceinline__ float row_rstd(const float* ssq, int row) {
    const f32x4 a = *(const f32x4*)(ssq + (size_t)row * 4);
    return __builtin_amdgcn_rsqf(((a[0] + a[1]) + (a[2] + a[3])) * (1.0f / 1024.0f) + 1e-6f);
}
struct EpiScaleBf16 {
    static constexpr bool PERM = true, AFTER_DRAIN = false;
    bf16_t* O; int ldc; const float* ssq; int row_off;
    int split_cols; size_t split_stride; float scale0;
    int ftile; float* lf; const float* bfv;
    __device__ __forceinline__ void operator()(const f32x4 (&acc)[2][2][4][2], const Unit& u, int wr, int wc, int fr, int fq) const {
        asm volatile("" : "+v"(fr), "+v"(fq));
        const int row0 = u.pm * BM + wr * 64 + fr;
        if (u.pn == ftile) {
            if (wc == 0 && fq == 0) {
                f32x4 b0 = *(const f32x4*)(bfv), b1 = *(const f32x4*)(bfv + 4);
#pragma unroll
                for (int ai = 0; ai < 2; ++ai)
#pragma unroll
                    for (int m = 0; m < 4; ++m) { const int row = row0 + ai * HALF + m * 16 + row_off; const float rs = row_rstd(ssq, row);
                        f32x4 v0 = acc[ai][0][m][0] * rs + b0, v1 = acc[ai][0][m][1] * rs + b1; f32x4 o0, o1;
#pragma unroll
                        for (int c = 0; c < 4; ++c) { float x = v0[c] * 1.4426950408889634f; o0[c] = fminf(x, 0.f) - __builtin_amdgcn_logf(1.f + __builtin_amdgcn_exp2f(-fabsf(x))); x = v1[c] * 1.4426950408889634f; o1[c] = fminf(x, 0.f) - __builtin_amdgcn_logf(1.f + __builtin_amdgcn_exp2f(-fabsf(x))); }
                        *(f32x4*)(lf + (size_t)row * 8) = o0; *(f32x4*)(lf + (size_t)row * 8 + 4) = o1; asm volatile("" ::: "memory"); }
            }
            return;
        }
        int colt = u.pn * BM; bf16_t* base = O; float sc = 1.f;
        if (split_cols) { const int t = colt / split_cols; base += (size_t)t * split_stride; colt -= t * split_cols; if (t == 0) sc = scale0; }
        const int col0 = colt + wc * 32 + 8 * fq;
        float rsv[2][4];
#pragma unroll
        for (int ai = 0; ai < 2; ++ai)
#pragma unroll
            for (int m = 0; m < 4; ++m) rsv[ai][m] = row_rstd(ssq, row0 + ai * HALF + m * 16 + row_off) * sc;
#pragma unroll
        for (int ai = 0; ai < 2; ++ai)
#pragma unroll
            for (int m = 0; m < 4; ++m) { const int row = row0 + ai * HALF + m * 16; const float rs = rsv[ai][m]; bf16_t* rowp = base + (size_t)row * ldc + col0;
#pragma unroll
                for (int bj = 0; bj < 2; ++bj) { const f32x4 v0 = acc[ai][bj][m][0] * rs, v1 = acc[ai][bj][m][1] * rs;
                    u32x4 w; w.x = cvt_pk_bf16(v0[0], v0[1]); w.y = cvt_pk_bf16(v0[2], v0[3]); w.z = cvt_pk_bf16(v1[0], v1[1]); w.w = cvt_pk_bf16(v1[2], v1[3]);
                    *(u32x4*)(rowp + bj * HALF) = w; } asm volatile("" ::: "memory"); }
    }
};
struct EpiResid {
    static constexpr bool PERM = true, AFTER_DRAIN = false;
    const float* base32; bf16_t* hb; float* ssq; int row_off; PG8_LAS float* P;
    __device__ __forceinline__ void operator()(const f32x4 (&acc)[2][2][4][2], const Unit& u, int wr, int wc, int fr, int fq) const {
        asm volatile("" : "+v"(fr), "+v"(fq));
        const int row0 = row_off + u.pm * BM + wr * 64 + fr, col0 = u.pn * BM + wc * 32 + 8 * fq;
#pragma unroll
        for (int ai = 0; ai < 2; ++ai) {
            u32x4 hv4[4][2];
            if (!base32) {
#pragma unroll
                for (int m = 0; m < 4; ++m)
#pragma unroll
                    for (int bj = 0; bj < 2; ++bj) hv4[m][bj] = *(const u32x4*)(hb + (size_t)(row0 + ai * HALF + m * 16) * 1024 + col0 + bj * HALF);
            }
#pragma unroll
            for (int m = 0; m < 4; ++m) { const int row = row0 + ai * HALF + m * 16; const size_t off = (size_t)row * 1024 + col0; float s = 0.f;
#pragma unroll
                for (int bj = 0; bj < 2; ++bj) { f32x4 b0, b1;
                    if (base32) { b0 = *(const f32x4*)(base32 + off + bj * HALF); b1 = *(const f32x4*)(base32 + off + bj * HALF + 4); }
                    else { const u32x4 hv = hv4[m][bj];
                        b0 = (f32x4){__builtin_bit_cast(float, hv.x << 16), __builtin_bit_cast(float, hv.x & 0xffff0000u), __builtin_bit_cast(float, hv.y << 16), __builtin_bit_cast(float, hv.y & 0xffff0000u)};
                        b1 = (f32x4){__builtin_bit_cast(float, hv.z << 16), __builtin_bit_cast(float, hv.z & 0xffff0000u), __builtin_bit_cast(float, hv.w << 16), __builtin_bit_cast(float, hv.w & 0xffff0000u)}; }
                    const f32x4 o0 = b0 + acc[ai][bj][m][0], o1 = b1 + acc[ai][bj][m][1];
                    s += ((o0[0] * o0[0] + o0[1] * o0[1]) + (o0[2] * o0[2] + o0[3] * o0[3])) + ((o1[0] * o1[0] + o1[1] * o1[1]) + (o1[2] * o1[2] + o1[3] * o1[3]));
                    u32x4 w; w.x = cvt_pk_bf16(o0[0], o0[1]); w.y = cvt_pk_bf16(o0[2], o0[3]); w.z = cvt_pk_bf16(o1[0], o1[1]); w.w = cvt_pk_bf16(o1[2], o1[3]); *(u32x4*)(hb + off + bj * HALF) = w; }
                s += __shfl_xor(s, 16); s += __shfl_xor(s, 32);
                if (fq == 0) P[(wr * 64 + ai * HALF + m * 16 + fr) * 4 + wc] = s;
                asm volatile("" ::: "memory"); }
        }
        asm volatile("s_waitcnt lgkmcnt(0)" ::: "memory"); __builtin_amdgcn_s_barrier(); asm volatile("" ::: "memory");
        { const int t = (wr * 4 + wc) * 64 + fq * 16 + fr; if (t < 256) { const f32x4 v = *(const PG8_LAS f32x4*)(P + t * 4); ssq[(size_t)(row_off + u.pm * BM + t) * 4 + u.pn] = (v[0] + v[1]) + (v[2] + v[3]); } }
    }
};
__device__ __forceinline__ float dpp_shr1(float v) { return __builtin_bit_cast(float, __builtin_amdgcn_update_dpp(0, __builtin_bit_cast(int, v), 0x111, 0xf, 0xf, true)); }
__device__ __forceinline__ float dpp_shr2(float v) { return __builtin_bit_cast(float, __builtin_amdgcn_update_dpp(0, __builtin_bit_cast(int, v), 0x112, 0xf, 0xf, true)); }
__device__ __forceinline__ float dpp_ror1(float v) { return __builtin_bit_cast(float, __builtin_amdgcn_update_dpp(0, __builtin_bit_cast(int, v), 0x121, 0xf, 0xf, false)); }
__device__ __forceinline__ float dpp_shl15(float v) { return __builtin_bit_cast(float, __builtin_amdgcn_update_dpp(0, __builtin_bit_cast(int, v), 0x10F, 0xf, 0xf, true)); }
__device__ __forceinline__ float dpp_shl14(float v) { return __builtin_bit_cast(float, __builtin_amdgcn_update_dpp(0, __builtin_bit_cast(int, v), 0x10E, 0xf, 0xf, true)); }
__device__ __forceinline__ float dpp_ror2(float v) { return __builtin_bit_cast(float, __builtin_amdgcn_update_dpp(0, __builtin_bit_cast(int, v), 0x122, 0xf, 0xf, false)); }
struct EpiFfnAct {
    static constexpr bool PERM = true, AFTER_DRAIN = false;
    bf16_t* act; const float* ssq; const float* cw; const float* cb; float* UH; float* AP; float* GP; PG8_LAS float* X;
    __device__ __forceinline__ void operator()(const f32x4 (&acc)[2][2][4][2], const Unit& u, int wr, int wc, int fr, int fq) const {
        asm volatile("" : "+v"(fr), "+v"(fq));
        constexpr int FF = 2816;
        const int wid = wr * 4 + wc, cl = 32 * wc + 8 * fq, col = u.pn * 128 + cl, row0 = u.pm * BM + wr * 64 + fr;
        const float rs3[2] = {row_rstd(ssq, row0 + 48), row_rstd(ssq, row0 + HALF + 48)};
#pragma unroll
        for (int ai = 0; ai < 2; ++ai) { const float rs = rs3[ai];
            if (fr >= 14) { const f32x4 a = acc[ai][0][3][0] * rs, b = acc[ai][0][3][1] * rs; PG8_LAS f32x4* xp = (PG8_LAS f32x4*)(X + ((wid * 2 + ai) * 2 + (fr - 14)) * 32 + fq * 8); xp[0] = a; xp[1] = b;
                if (wr == 1 && ai == 1) { float* g = UH + ((size_t)u.pm * 2 + (fr - 14)) * FF + col; *(f32x4*)g = a; *(f32x4*)(g + 4) = b; } } }
        asm volatile("s_waitcnt lgkmcnt(0)" ::: "memory"); __builtin_amdgcn_s_barrier(); asm volatile("" ::: "memory");
        const f32x4 w0a = *(const f32x4*)(cw + col), w0b = *(const f32x4*)(cw + col + 4), w1a = *(const f32x4*)(cw + FF + col), w1b = *(const f32x4*)(cw + FF + col + 4);
        const f32x4 w2a = *(const f32x4*)(cw + 2 * FF + col), w2b = *(const f32x4*)(cw + 2 * FF + col + 4), ba = *(const f32x4*)(cb + col), bb = *(const f32x4*)(cb + col + 4);
        const float m0 = (fr == 0) ? 1.f : 0.f, m1 = (fr == 1) ? 1.f : 0.f;
#pragma unroll
        for (int ai = 0; ai < 2; ++ai) {
            f32x4 pa = {0.f, 0.f, 0.f, 0.f}, pb = {0.f, 0.f, 0.f, 0.f};
            float rsv[4];
#pragma unroll
            for (int m = 0; m < 4; ++m) rsv[m] = row_rstd(ssq, row0 + ai * HALF + m * 16);
#pragma unroll
            for (int m = 0; m < 4; ++m) {
                const int row = row0 + ai * HALF + m * 16; const float rs = rsv[m];
                const f32x4 ca = acc[ai][0][m][0] * rs, cb_ = acc[ai][0][m][1] * rs;
                f32x4 aa = w2a * ca + ba, ab = w2b * cb_ + bb;
#pragma unroll
                for (int c = 0; c < 4; ++c) { aa[c] = __builtin_fmaf(w1a[c], dpp_shr1(ca[c]), aa[c]); ab[c] = __builtin_fmaf(w1b[c], dpp_shr1(cb_[c]), ab[c]);
                    aa[c] = __builtin_fmaf(w0a[c], dpp_shr2(ca[c]), aa[c]); ab[c] = __builtin_fmaf(w0b[c], dpp_shr2(cb_[c]), ab[c]); }
                if (m == 0) {
                    if (ai == 1 || wr == 1) { const int sw = ((ai == 1 && wr == 0) ? 4 : 0) + wc, sai = (ai == 1 && wr == 1) ? 1 : 0;
                        const PG8_LAS f32x4* xp = (const PG8_LAS f32x4*)(X + ((sw * 2 + sai) * 2) * 32 + fq * 8); const f32x4 h0a = xp[0], h0b = xp[1], h1a = xp[8], h1b = xp[9];
                        aa += w1a * (h1a * m0) + w0a * (h0a * m0 + h1a * m1); ab += w1b * (h1b * m0) + w0b * (h0b * m0 + h1b * m1); }
                } else {
#pragma unroll
                    for (int c = 0; c < 4; ++c) { aa[c] = __builtin_fmaf(w1a[c], dpp_shl15(pa[c]), aa[c]); ab[c] = __builtin_fmaf(w1b[c], dpp_shl15(pb[c]), ab[c]);
                        aa[c] = __builtin_fmaf(w0a[c], dpp_shl14(pa[c]), aa[c]); ab[c] = __builtin_fmaf(w0b[c], dpp_shl14(pb[c]), ab[c]); }
                }
                const f32x4 ga = acc[ai][1][m][0] * rs, gb = acc[ai][1][m][1] * rs;
                f32x4 ea = aa * -1.4426950408889634f, eb = ab * -1.4426950408889634f;
#pragma unroll
                for (int c = 0; c < 4; ++c) { ea[c] = __builtin_amdgcn_exp2f(ea[c]); eb[c] = __builtin_amdgcn_exp2f(eb[c]); }
                ea = ea + 1.0f; eb = eb + 1.0f;
#pragma unroll
                for (int c = 0; c < 4; ++c) { ea[c] = __builtin_amdgcn_rcpf(ea[c]); eb[c] = __builtin_amdgcn_rcpf(eb[c]); }
                const f32x4 oa = (aa * ga) * ea, ob = (ab * gb) * eb;
                u32x4 w; w.x = cvt_pk_bf16(oa[0], oa[1]); w.y = cvt_pk_bf16(oa[2], oa[3]); w.z = cvt_pk_bf16(ob[0], ob[1]); w.w = cvt_pk_bf16(ob[2], ob[3]);
                *(u32x4*)(act + (size_t)row * FF + col) = w;
                if (m == 0 && ai == 0 && wr == 0 && fr < 2 && (u.pm & 15) != 0) { float* g = AP + ((size_t)u.pm * 2 + fr) * FF + col; *(f32x4*)g = aa; *(f32x4*)(g + 4) = ab;
                    float* g2 = GP + ((size_t)u.pm * 2 + fr) * FF + col; *(f32x4*)g2 = ga; *(f32x4*)(g2 + 4) = gb; }
                pa = ca; pb = cb_;
                asm volatile("" ::: "memory");
            }
        }
    }
};
template <class Epi, class Sched, bool ALIGN_EPI = false, bool SP2 = false>
__device__ __forceinline__ void gemm_phase(PG8_LAS unsigned char* lds, const Gemm g, const Sched& S, const Epi& E) {
    int tid_ = threadIdx.x; asm volatile("" : "+v"(tid_));
    const int tid = tid_, wid = __builtin_amdgcn_readfirstlane(tid >> 6), lane = tid & 63, wr = wid >> 2, wc = wid & 3, fr = lane & 15, fq = lane >> 4;
    const int K = g.K, nt = K / BK;
    unsigned voffA[2], voffB[2];
#pragma unroll
    for (int i = 0; i < 2; ++i) { int R, C; stage_rc(tid * 16 + i * 8192, R, C); const int Rb = Epi::PERM ? ((R & ~31) + perm32(R & 31)) : R;
        voffA[i] = (unsigned)(R * K + C) * 2u; voffB[i] = (unsigned)(Rb * K + C) * 2u; }
    const size_t kstep = (size_t)(BK * 2);
    const size_t hstep = (size_t)HALF * K * 2;
    const size_t tstep = 2 * hstep;
    const unsigned ldsw = (unsigned)wid * 1024u;
    const int aoff = lds_byte(wr * 64 + fr, fq * 8), boff = lds_byte(wc * 32 + fr, fq * 8);
#define PG8_SA(b, h) (((b) * 2 + (h)) * HTB)
#define PG8_SB(b, h) ((4 + (b) * 2 + (h)) * HTB)
#define PG8_STAGE(bufoff, gbase, voff) do { _Pragma("unroll") for (int _i = 0; _i < 2; ++_i) \
        __builtin_amdgcn_global_load_lds((const unsigned*)((const char*)(gbase) + (voff)[_i]), (PG8_LAS unsigned*)(lds + (bufoff) + ldsw + _i * 8192), 16, 0, 0); } while (0)
#define PG8_LDA(dst, b, h) do { _Pragma("unroll") for (int m = 0; m < 4; ++m) _Pragma("unroll") for (int k = 0; k < 2; ++k) dst[m][k] = *(const PG8_LAS bf16x8*)(lds + PG8_SA(b, h) + aoff + m * 2048 + k * 1024); } while (0)
#define PG8_LDB(dst, b, h) do { _Pragma("unroll") for (int n = 0; n < 2; ++n) _Pragma("unroll") for (int k = 0; k < 2; ++k) dst[n][k] = *(const PG8_LAS bf16x8*)(lds + PG8_SB(b, h) + boff + n * 2048 + k * 1024); } while (0)
#define PG8_MMA(ai, bj, At, Bt) do { __builtin_amdgcn_s_setprio(1); _Pragma("unroll") for (int m = 0; m < 4; ++m) _Pragma("unroll") for (int n = 0; n < 2; ++n) _Pragma("unroll") for (int k = 0; k < 2; ++k) \
        acc[ai][bj][m][n] = __builtin_amdgcn_mfma_f32_16x16x32_bf16(Bt[n][k], At[m][k], acc[ai][bj][m][n], 0, 0, 0); __builtin_amdgcn_s_setprio(0); } while (0)
#define PG8_WAIT_V(n) asm volatile("s_waitcnt vmcnt(" #n ")" ::: "memory")
#define PG8_WAIT_L(n) asm volatile("s_waitcnt lgkmcnt(" #n ")" ::: "memory")
#define PG8_BAR __builtin_amdgcn_s_barrier()
#define PG8_SCHED __builtin_amdgcn_sched_barrier(0)
    Unit cur, nxt; int ui = 0;
    if (!S.next(0, cur)) return;
    f32x4 acc[2][2][4][2];
#pragma unroll
    for (int a = 0; a < 2; ++a)
#pragma unroll
        for (int b = 0; b < 2; ++b)
#pragma unroll
            for (int m = 0; m < 4; ++m)
#pragma unroll
                for (int n = 0; n < 2; ++n) acc[a][b][m][n] = (f32x4){0.f, 0.f, 0.f, 0.f};
    bf16x8 At[4][2], B0[2][2], B1[2][2];
    const char* cA = (const char*)g.A + (size_t)cur.pm * tstep; const char* cB = (const char*)g.Bt + (size_t)cur.pn * tstep;
    S.a_ready(cur);
    if constexpr (SP2) {
        PG8_STAGE(PG8_SB(0, 0), cB, voffB); PG8_STAGE(PG8_SB(0, 1), cB + hstep, voffB); PG8_STAGE(PG8_SA(0, 0), cA, voffA); PG8_STAGE(PG8_SA(0, 1), cA + hstep, voffA);
        if (wr == 1) PG8_BAR;
        PG8_WAIT_V(2); PG8_BAR;
        PG8_STAGE(PG8_SB(1, 0), cB + kstep, voffB); PG8_STAGE(PG8_SA(1, 0), cA + kstep, voffA); PG8_STAGE(PG8_SB(1, 1), cB + hstep + kstep, voffB);
        PG8_WAIT_V(6); PG8_BAR;
    } else {
        PG8_STAGE(PG8_SB(0, 0), cB, voffB); PG8_STAGE(PG8_SA(0, 0), cA, voffA); PG8_STAGE(PG8_SB(0, 1), cB + hstep, voffB); PG8_STAGE(PG8_SA(0, 1), cA + hstep, voffA);
        if (wr == 1) PG8_BAR;
        PG8_WAIT_V(4); PG8_BAR;
        PG8_STAGE(PG8_SB(1, 0), cB + kstep, voffB); PG8_STAGE(PG8_SA(1, 0), cA + kstep, voffA); PG8_STAGE(PG8_SB(1, 1), cB + hstep + kstep, voffB);
        PG8_WAIT_V(6); PG8_BAR;
    }
    for (;;) {
        const bool has_next = S.next(ui + 1, nxt);
        const char* nA = has_next ? (const char*)g.A + (size_t)nxt.pm * tstep : cA; const char* nB = has_next ? (const char*)g.Bt + (size_t)nxt.pn * tstep : cB;
        for (int t = 0; t < nt; t += 2) {
            const bool last = (t == nt - 2);
            const char* a1 = cA + (size_t)(t + 1) * kstep;
            const char* a2 = last ? nA : cA + (size_t)(t + 2) * kstep; const char* b2 = last ? nB : cB + (size_t)(t + 2) * kstep;
            const char* a3 = a2 + kstep; const char* b3 = b2 + kstep;
            if (last && has_next) S.a_ready(nxt);
            if constexpr (SP2) {
            PG8_LDB(B0, 0, 0); PG8_LDB(B1, 0, 1); PG8_SCHED; PG8_LDA(At, 0, 0); PG8_STAGE(PG8_SA(1, 1), a1 + hstep, voffA);
            PG8_WAIT_V(8); PG8_WAIT_L(0); PG8_BAR; PG8_MMA(0, 0, At, B0); PG8_MMA(0, 1, At, B1); PG8_BAR; PG8_SCHED;
            PG8_LDA(At, 0, 1); PG8_STAGE(PG8_SB(0, 0), b2, voffB); PG8_STAGE(PG8_SB(0, 1), b2 + hstep, voffB); PG8_STAGE(PG8_SA(0, 0), a2, voffA);
            PG8_WAIT_V(8); PG8_WAIT_L(0); PG8_BAR; PG8_MMA(1, 0, At, B0); PG8_MMA(1, 1, At, B1); PG8_BAR; PG8_SCHED;
            PG8_LDB(B0, 1, 0); PG8_LDB(B1, 1, 1); PG8_SCHED; PG8_LDA(At, 1, 0); PG8_STAGE(PG8_SA(0, 1), a2 + hstep, voffA);
            PG8_WAIT_V(8); PG8_WAIT_L(0); PG8_BAR; PG8_MMA(0, 0, At, B0); PG8_MMA(0, 1, At, B1); PG8_BAR; PG8_SCHED;
            PG8_LDA(At, 1, 1); PG8_STAGE(PG8_SB(1, 0), b3, voffB); PG8_STAGE(PG8_SB(1, 1), b3 + hstep, voffB); PG8_STAGE(PG8_SA(1, 0), a3, voffA);
            PG8_WAIT_V(8); PG8_WAIT_L(0); PG8_BAR; PG8_MMA(1, 0, At, B0); PG8_MMA(1, 1, At, B1); PG8_BAR; PG8_SCHED;
            } else {
            PG8_LDB(B0, 0, 0); PG8_SCHED; PG8_LDA(At, 0, 0); PG8_STAGE(PG8_SA(1, 1), a1 + hstep, voffA);
            PG8_WAIT_L(8); PG8_BAR; PG8_WAIT_L(0); PG8_MMA(0, 0, At, B0); PG8_BAR; PG8_SCHED;
            PG8_LDB(B1, 0, 1); PG8_STAGE(PG8_SB(0, 0), b2, voffB);
            PG8_BAR; PG8_WAIT_L(0); PG8_MMA(0, 1, At, B1); PG8_BAR;
            PG8_LDA(At, 0, 1); PG8_STAGE(PG8_SA(0, 0), a2, voffA);
            PG8_BAR; PG8_WAIT_L(0); PG8_MMA(1, 0, At, B0); PG8_BAR; PG8_SCHED;
            PG8_STAGE(PG8_SB(0, 1), b2 + hstep, voffB);
            PG8_WAIT_V(6); PG8_BAR; PG8_MMA(1, 1, At, B1); PG8_BAR;
            PG8_LDB(B0, 1, 0); PG8_SCHED; PG8_LDA(At, 1, 0); PG8_STAGE(PG8_SA(0, 1), a2 + hstep, voffA);
            PG8_WAIT_L(8); PG8_BAR; PG8_WAIT_L(0); PG8_MMA(0, 0, At, B0); PG8_BAR; PG8_SCHED;
            PG8_LDB(B1, 1, 1); PG8_STAGE(PG8_SB(1, 0), b3, voffB);
            PG8_BAR; PG8_WAIT_L(0); PG8_MMA(0, 1, At, B1); PG8_BAR;
            PG8_LDA(At, 1, 1); PG8_STAGE(PG8_SA(1, 0), a3, voffA);
            PG8_BAR; PG8_WAIT_L(0); PG8_MMA(1, 0, At, B0); PG8_BAR; PG8_SCHED;
            PG8_STAGE(PG8_SB(1, 1), b3 + hstep, voffB);
            PG8_WAIT_V(6); PG8_BAR; PG8_MMA(1, 1, At, B1); PG8_BAR;
            }
        }
        if constexpr (ALIGN_EPI) { if (wr == 0) PG8_BAR; }
        if constexpr (!Epi::AFTER_DRAIN) { E(acc, cur, wr, wc, fr, fq); S.done(cur); }
        if (!has_next) break;
#pragma unroll
        for (int a = 0; a < 2; ++a)
#pragma unroll
            for (int b = 0; b < 2; ++b)
#pragma unroll
                for (int m = 0; m < 4; ++m)
#pragma unroll
                    for (int n = 0; n < 2; ++n) acc[a][b][m][n] = (f32x4){0.f, 0.f, 0.f, 0.f};
        cur = nxt; cA = nA; cB = nB; ++ui;
        if constexpr (ALIGN_EPI) { if (wr == 1) PG8_BAR; }
    }
    PG8_WAIT_V(0);
    if constexpr (!ALIGN_EPI) { if (wr == 0) PG8_BAR; }
    PG8_BAR;
    if constexpr (Epi::AFTER_DRAIN) { E.fused(acc, cur, wr, wc, fr, fq, lds, wid, lane); S.done(cur); }
#undef PG8_SA
#undef PG8_SB
#undef PG8_STAGE
#undef PG8_LDA
#undef PG8_LDB
#undef PG8_MMA
#undef PG8_WAIT_V
#undef PG8_WAIT_L
#undef PG8_BAR
#undef PG8_SCHED
}
}

typedef unsigned short bf16_t;
typedef short bf16x8 __attribute__((ext_vector_type(8)));
typedef float f32x4 __attribute__((ext_vector_type(4)));
typedef unsigned u32x4 __attribute__((ext_vector_type(4)));
typedef unsigned u32x2 __attribute__((ext_vector_type(2)));
#define LAS __attribute__((address_space(3)))
constexpr int MROWS = 32768, DM = 1024, SEQ = 4096, NB = 8, DFF = 2816;
constexpr int EV_N = 2048, OD_N = 3080, OD_NP = 3328, FF_N = 5632;
constexpr float LOG2E = 1.4426950408889634f;
constexpr int NTHREADS = 512, NWAVES = 8;
constexpr int LDS_BYTES = 163840;
constexpr size_t MiB = 1u << 20;
constexpr size_t WS_EVIN = 0, WS_EVOUT = 8 * MiB, WS_ODIN = 12 * MiB, WS_ODOUT = 25 * MiB, WS_FFIN = 29 * MiB, WS_FFOUT = 73 * MiB, WS_POOL = 95 * MiB;
constexpr size_t WS_KNT = 100 * MiB + 768 * 1024;
constexpr size_t WS_SSQ = 96 * MiB, WS_LF = 98 * MiB, WS_F2 = 99 * MiB, WS_KMEAN = 100 * MiB, WS_HB = 101 * MiB, WS_R2 = 165 * MiB, WS_R1 = 253 * MiB, WS_END = 445 * MiB;
constexpr int FF_HALVES = 2, MH = MROWS / FF_HALVES;

struct Params { const float* in[17]; float* out; unsigned char* ws; int ph_lo, ph_hi; };
enum { I_X = 0, I_MIXG, I_FFNG, I_FING, I_EVWIN, I_EVCONV, I_EVPOOLW, I_EVPOOLS, I_EVWOUT, I_ODWIN, I_ODBF, I_ODWOUT, I_RELB, I_FFWIN, I_FFCONVW, I_FFCONVB, I_FFWOUT };

__device__ __forceinline__ unsigned f2bf(float f) { unsigned u = __builtin_bit_cast(unsigned, f); return (u + 0x7fffu + ((u >> 16) & 1u)) >> 16; }
typedef float f32x2_t __attribute__((ext_vector_type(2))); typedef __bf16 bf16x2_t __attribute__((ext_vector_type(2)));
__device__ __forceinline__ unsigned pk2(float lo, float hi) { const f32x2_t v = {lo, hi}; const bf16x2_t b = __builtin_convertvector(v, bf16x2_t); return __builtin_bit_cast(unsigned, b); }
__device__ __forceinline__ float bf_lo(unsigned u) { return __builtin_bit_cast(float, u << 16); }
__device__ __forceinline__ float bf_hi(unsigned u) { return __builtin_bit_cast(float, u & 0xffff0000u); }
__device__ __forceinline__ float wave_sum(float v) {
#pragma unroll
    for (int o = 1; o < 64; o <<= 1) v += __shfl_xor(v, o);
    return v;
}

__device__ __forceinline__ void transpose_item(const float* W, int K, int N, int NP, bf16_t* WT, const float* gvec, int mode, float* scr, int item, int lane, const float* nvec = nullptr) {
    const int nblk = NP / 64, kb = item / nblk, nb = item % nblk, k0 = 64 * kb, n0 = 64 * nb;
    const int nq = 4 * (lane & 15), n = n0 + nq;
#pragma unroll 8
    for (int i = 0; i < 16; ++i) { const int kk = 4 * i + (lane >> 4);
        f32x4 v = {0.f, 0.f, 0.f, 0.f}; if (n < N) v = *(const f32x4*)(W + (size_t)(k0 + kk) * N + n); if (gvec) v = v * gvec[k0 + kk];
        float* d = scr + kk * 65 + nq; d[0] = v[0]; d[1] = v[1]; d[2] = v[2]; d[3] = v[3]; }
    asm volatile("s_waitcnt lgkmcnt(0)" ::: "memory");
    const int c = lane & 7;
#pragma unroll
    for (int j = 0; j < 8; ++j) { const int nl = (lane >> 3) + 8 * j; const float* sp = scr + (8 * c) * 65 + nl; int nn = n0 + nl;
        if (mode == 1) { nn = (nn < DFF) ? ((nn >> 7) * 256 + (nn & 127)) : ((((nn - DFF) >> 7) * 256) + 128 + ((nn - DFF) & 127)); }
        const float ns = nvec ? nvec[n0 + nl] : 1.0f;
        u32x4 o; o.x = pk2(sp[0 * 65] * ns, sp[1 * 65] * ns); o.y = pk2(sp[2 * 65] * ns, sp[3 * 65] * ns); o.z = pk2(sp[4 * 65] * ns, sp[5 * 65] * ns); o.w = pk2(sp[6 * 65] * ns, sp[7 * 65] * ns);
        *(u32x4*)(WT + (size_t)nn * K + k0 + 8 * c) = o; }
    asm volatile("s_waitcnt lgkmcnt(0)" ::: "memory");
}
__device__ __forceinline__ void phase_prologue(const Params& p, unsigned char* lds) {
    int tid_ = threadIdx.x; asm volatile("" : "+v"(tid_)); const int tid = tid_, lane = tid & 63, wave = tid >> 6;
    float* scr = (float*)(lds + wave * 16896);
    const int gw = blockIdx.x * NWAVES + wave, NGW = gridDim.x * NWAVES;
    unsigned char* ws = p.ws;
    constexpr int I_EI = 16 * (EV_N / 64), I_EO = 16 * 16, I_OI = 16 * (OD_NP / 64), I_OO = 16 * 16, I_FI = 16 * (FF_N / 64), I_FO = (DFF / 64) * 16, I_PW = 2 * 2;
    constexpr int NITEMS = 2 * I_EI + 2 * I_EO + 2 * I_OI + 2 * I_OO + 4 * I_FI + 4 * I_FO + 8 * I_PW;
    for (int it = gw; it < NITEMS; it += NGW) {
        int r = it;
        if (r < 2 * I_EI) { const int e = r / I_EI; transpose_item(p.in[I_EVWIN] + (size_t)e * DM * EV_N, DM, EV_N, EV_N, (bf16_t*)(ws + WS_EVIN) + (size_t)e * EV_N * DM, p.in[I_MIXG] + (2 * e) * DM, 0, scr, r % I_EI, lane); continue; } r -= 2 * I_EI;
        if (r < 2 * I_EO) { const int e = r / I_EO; transpose_item(p.in[I_EVWOUT] + (size_t)e * DM * DM, DM, DM, DM, (bf16_t*)(ws + WS_EVOUT) + (size_t)e * DM * DM, nullptr, 0, scr, r % I_EO, lane); continue; } r -= 2 * I_EO;
        if (r < 2 * I_OI) { const int e = r / I_OI; transpose_item(p.in[I_ODWIN] + (size_t)e * DM * OD_N, DM, OD_N, OD_NP, (bf16_t*)(ws + WS_ODIN) + (size_t)e * OD_NP * DM, p.in[I_MIXG] + (2 * e + 1) * DM, 0, scr, r % I_OI, lane); continue; } r -= 2 * I_OI;
        if (r < 2 * I_OO) { const int e = r / I_OO; transpose_item(p.in[I_ODWOUT] + (size_t)e * DM * DM, DM, DM, DM, (bf16_t*)(ws + WS_ODOUT) + (size_t)e * DM * DM, nullptr, 0, scr, r % I_OO, lane); continue; } r -= 2 * I_OO;
        if (r < 4 * I_FI) { const int e = r / I_FI; transpose_item(p.in[I_FFWIN] + (size_t)e * DM * FF_N, DM, FF_N, FF_N, (bf16_t*)(ws + WS_FFIN) + (size_t)e * FF_N * DM, p.in[I_FFNG] + e * DM, 1, scr, r % I_FI, lane); continue; } r -= 4 * I_FI;
        if (r < 4 * I_FO) { const int e = r / I_FO; transpose_item(p.in[I_FFWOUT] + (size_t)e * DFF * DM, DFF, DM, DM, (bf16_t*)(ws + WS_FFOUT) + (size_t)e * DM * DFF, nullptr, 0, scr, r % I_FO, lane); continue; } r -= 4 * I_FO;
        { const int e = r / I_PW; transpose_item(p.in[I_EVPOOLW] + (size_t)e * 128 * 128, 128, 128, 128, (bf16_t*)(ws + WS_POOL) + (size_t)e * 128 * 128, nullptr, 0, scr, r % I_PW, lane, p.in[I_EVPOOLS] + (size_t)e * 128); }
    }
    const float* x = p.in[I_X]; bf16_t* hb = (bf16_t*)(ws + WS_HB); float* ssq = (float*)(ws + WS_SSQ);
    { f32x4 nv[4];
      if (gw < MROWS) { const f32x4* xr = (const f32x4*)(x + (size_t)gw * DM) + lane;
#pragma unroll
          for (int j = 0; j < 4; ++j) nv[j] = xr[64 * j]; }
      for (int m = gw; m < MROWS; m += NGW) {
        f32x4 v[4]; float s = 0.f;
#pragma unroll
        for (int j = 0; j < 4; ++j) v[j] = nv[j];
        if (m + NGW < MROWS) { const f32x4* xr = (const f32x4*)(x + (size_t)(m + NGW) * DM) + lane;
#pragma unroll
            for (int j = 0; j < 4; ++j) nv[j] = xr[64 * j]; }
#pragma unroll
        for (int j = 0; j < 4; ++j) s += (v[j][0] * v[j][0] + v[j][1] * v[j][1]) + (v[j][2] * v[j][2] + v[j][3] * v[j][3]);
        s = wave_sum(s);
        u32x2* o8 = (u32x2*)(hb + (size_t)m * DM) + lane;
#pragma unroll
        for (int j = 0; j < 4; ++j) { u32x2 w; w.x = pk2(v[j][0], v[j][1]); w.y = pk2(v[j][2], v[j][3]); o8[64 * j] = w; }
        if (lane < 4) ssq[(size_t)m * 4 + lane] = (lane == 0) ? s : 0.f;
      } }
}

__device__ __forceinline__ void phase_evmix(const Params& p, unsigned char* lds, int e) {
    int tid_ = threadIdx.x; asm volatile("" : "+v"(tid_)); const int tid = tid_, lane = tid & 63, wave = tid >> 6, fr = lane & 15, fq = lane >> 4;
    const bf16_t* z = (const bf16_t*)(p.ws + WS_R1); bf16_t* y = (bf16_t*)(p.ws + WS_R2);
    const float* cw = p.in[I_EVCONV] + (size_t)e * 3 * 512;
    const bf16_t* poolT = (const bf16_t*)(p.ws + WS_POOL) + (size_t)e * 4 * 128 * 128;
    float* CV = (float*)lds;
    bf16_t* Zp = (bf16_t*)lds;
    bf16_t* Pl = (bf16_t*)(lds + 40960);
    bf16_t* Bl = (bf16_t*)(lds + 77824);
    u32x4 pa[5], pb[5], pg[4];
    const int NU = 256 * 8, G = gridDim.x;
#define EV_LOAD(uu) do { const int part_ = (uu) & 7, t0_ = ((uu) >> 3) * 128, pos0_ = t0_ & (SEQ - 1); \
        if (part_ < 4) { const int cb_ = part_ * 128; \
            _Pragma("unroll") for (int k = 0; k < 5; ++k) { const int it_ = tid + k * NTHREADS; const int r_ = it_ >> 4, ch_ = it_ & 15; pa[k] = (u32x4){0u, 0u, 0u, 0u}; pb[k] = pa[k]; \
                if (it_ < 130 * 16 && pos0_ + r_ - 2 >= 0) { pa[k] = *(const u32x4*)(z + (size_t)(t0_ + r_ - 2) * EV_N + 512 + cb_ + ch_ * 8); pb[k] = *(const u32x4*)(z + (size_t)(t0_ + r_ - 2) * EV_N + 1024 + cb_ + ch_ * 8); } } \
            _Pragma("unroll") for (int k = 0; k < 4; ++k) { const int it_ = tid + k * NTHREADS; pg[k] = *(const u32x4*)(z + (size_t)(t0_ + (it_ >> 4)) * EV_N + cb_ + (it_ & 15) * 8); } \
        } else { const int cb_ = 1536 + (part_ - 4) * 128; \
            _Pragma("unroll") for (int k = 0; k < 5; ++k) { const int it_ = tid + k * NTHREADS; const int r_ = it_ >> 4, ch_ = it_ & 15; pa[k] = (u32x4){0u, 0u, 0u, 0u}; \
                if (it_ < 143 * 16 && pos0_ + r_ - 15 >= 0) pa[k] = *(const u32x4*)(z + (size_t)(t0_ + r_ - 15) * EV_N + cb_ + ch_ * 8); } } } while (0)
    int gl = -1;
    int u = blockIdx.x;
    if (u < NU) EV_LOAD(u);
    for (; u < NU; u += G) {
        const int part = u & 7, rt = u >> 3; const int t0 = rt * 128; const int pos0 = t0 & (SEQ - 1);
        __syncthreads();
        if (part < 4) {
            const int cbase = part * 128, c0 = cbase + (tid & 15) * 8;
            const f32x4 w0a = *(const f32x4*)(cw + c0), w0b = *(const f32x4*)(cw + c0 + 4), w1a = *(const f32x4*)(cw + 512 + c0), w1b = *(const f32x4*)(cw + 512 + c0 + 4), w2a = *(const f32x4*)(cw + 1024 + c0), w2b = *(const f32x4*)(cw + 1024 + c0 + 4);
#pragma unroll
            for (int k = 0; k < 5; ++k) { const int it = tid + k * NTHREADS; if (it < 130 * 16) { const int r = it >> 4, ch = it & 15; const u32x4 gc = pa[k], vv = pb[k];
                const f32x4 a = {bf_lo(gc[0]) * bf_lo(vv[0]), bf_hi(gc[0]) * bf_hi(vv[0]), bf_lo(gc[1]) * bf_lo(vv[1]), bf_hi(gc[1]) * bf_hi(vv[1])};
                const f32x4 b = {bf_lo(gc[2]) * bf_lo(vv[2]), bf_hi(gc[2]) * bf_hi(vv[2]), bf_lo(gc[3]) * bf_lo(vv[3]), bf_hi(gc[3]) * bf_hi(vv[3])};
                *(f32x4*)(CV + r * 128 + ch * 8) = a; *(f32x4*)(CV + r * 128 + ch * 8 + 4) = b; } }
            u32x4 gb[4];
#pragma unroll
            for (int k = 0; k < 4; ++k) gb[k] = pg[k];
            if (u + G < NU) EV_LOAD(u + G);
            __syncthreads();
#pragma unroll
            for (int k = 0; k < 4; ++k) { const int it = tid + k * NTHREADS; const int r = it >> 4;
                const float* cp = CV + r * 128 + (tid & 15) * 8;
                const f32x4 ca = w0a * *(const f32x4*)(cp) + w1a * *(const f32x4*)(cp + 128) + w2a * *(const f32x4*)(cp + 256);
                const f32x4 cb = w0b * *(const f32x4*)(cp + 4) + w1b * *(const f32x4*)(cp + 132) + w2b * *(const f32x4*)(cp + 260);
                const u32x4 g = gb[k]; u32x4 w;
                w.x = pk2(bf_lo(g[0]) * ca[0], bf_hi(g[0]) * ca[1]); w.y = pk2(bf_lo(g[1]) * ca[2], bf_hi(g[1]) * ca[3]); w.z = pk2(bf_lo(g[2]) * cb[0], bf_hi(g[2]) * cb[1]); w.w = pk2(bf_lo(g[3]) * cb[2], bf_hi(g[3]) * cb[3]);
                *(u32x4*)(y + (size_t)(t0 + r) * DM + c0) = w; }
        } else {
            const int g = part - 4, win = 2 << g;
            if (g != gl) {
                const bf16_t* Bt = poolT + (size_t)g * 128 * 128;
#pragma unroll
                for (int k = 0; k < 4; ++k) { const int it = tid + k * NTHREADS; const int n = it >> 4, ch = it & 15; *(u32x4*)(Bl + n * 136 + ch * 8) = *(const u32x4*)(Bt + (size_t)n * 128 + ch * 8); }
                gl = g; }
#pragma unroll
            for (int k = 0; k < 5; ++k) { const int it = tid + k * NTHREADS; if (it < 143 * 16) *(u32x4*)(Zp + (it >> 4) * 128 + (it & 15) * 8) = pa[k]; }
            if (u + G < NU) EV_LOAD(u + G);
            __syncthreads();
#pragma unroll
            for (int k = 0; k < 4; ++k) { const int it = tid + k * NTHREADS; const int r = it >> 4, ch = it & 15; const int pos = pos0 + r;
                float sum[8];
#pragma unroll
                for (int j = 0; j < 8; ++j) sum[j] = 0.f;
                for (int i = 0; i < win; ++i) { const u32x4 v = *(const u32x4*)(Zp + (r + 15 - i) * 128 + ch * 8);
#pragma unroll
                    for (int j = 0; j < 4; ++j) { sum[2 * j] += bf_lo(v[j]); sum[2 * j + 1] += bf_hi(v[j]); } }
                const u32x4 xv = *(const u32x4*)(Zp + (r + 15) * 128 + ch * 8); const float inv = 1.0f / (float)((pos + 1 < win) ? pos + 1 : win);
                u32x4 w;
                w.x = pk2(sum[0] * inv - bf_lo(xv[0]), sum[1] * inv - bf_hi(xv[0])); w.y = pk2(sum[2] * inv - bf_lo(xv[1]), sum[3] * inv - bf_hi(xv[1]));
                w.z = pk2(sum[4] * inv - bf_lo(xv[2]), sum[5] * inv - bf_hi(xv[2])); w.w = pk2(sum[6] * inv - bf_lo(xv[3]), sum[7] * inv - bf_hi(xv[3]));
                *(u32x4*)(Pl + r * 136 + ch * 8) = w; }
            __syncthreads();
            f32x4 acc[8];
#pragma unroll
            for (int nb = 0; nb < 8; ++nb) acc[nb] = (f32x4){0.f, 0.f, 0.f, 0.f};
#pragma unroll
            for (int ks = 0; ks < 4; ++ks) { const bf16x8 a = *(const bf16x8*)(Pl + (16 * wave + fr) * 136 + 32 * ks + 8 * fq);
#pragma unroll
                for (int nb = 0; nb < 8; ++nb) { const bf16x8 b = *(const bf16x8*)(Bl + (16 * nb + fr) * 136 + 32 * ks + 8 * fq); acc[nb] = __builtin_amdgcn_mfma_f32_16x16x32_bf16(b, a, acc[nb], 0, 0, 0); } }
            const int row = rt * 128 + 16 * wave + fr;
#pragma unroll
            for (int nb = 0; nb < 8; ++nb) { const int col = g * 128 + 16 * nb + 4 * fq; const f32x4 o = acc[nb];
                u32x2 w; w.x = pk2(o[0], o[1]); w.y = pk2(o[2], o[3]); *(u32x2*)(y + (size_t)row * DM + 512 + col) = w; }
        }
    }
#undef EV_LOAD
    __syncthreads();
}

__device__ __forceinline__ void phase_ffnact(const Params& p, int layer, const bf16_t* ug, bf16_t* act, int rows) {
    const float* cw = p.in[I_FFCONVW] + (size_t)layer * 3 * DFF; const float* cb = p.in[I_FFCONVB] + (size_t)layer * DFF;
    constexpr int NCH = DFF / 8, RUN = 16;
    const int nitems = (rows / RUN) * NCH;
    int tid_ = threadIdx.x; asm volatile("" : "+v"(tid_));
    for (int it = blockIdx.x * NTHREADS + tid_; it < nitems; it += gridDim.x * NTHREADS) {
        const int ch = it % NCH, rr = it / NCH; const int c0 = ch * 8; const int t0 = rr * RUN, pos0 = t0 & (SEQ - 1);
        const int ucol = (c0 >> 7) * 256 + (c0 & 127);
        float w0[8], w1[8], w2[8], bb[8];
#pragma unroll
        for (int j = 0; j < 8; ++j) { w0[j] = cw[c0 + j]; w1[j] = cw[DFF + c0 + j]; w2[j] = cw[2 * DFF + c0 + j]; bb[j] = cb[c0 + j]; }
        float u1[8], u2[8];
#pragma unroll
        for (int j = 0; j < 8; ++j) { u1[j] = 0.f; u2[j] = 0.f; }
        if (pos0 >= 2) { const u32x4 a = *(const u32x4*)(ug + (size_t)(t0 - 2) * FF_N + ucol), b = *(const u32x4*)(ug + (size_t)(t0 - 1) * FF_N + ucol);
#pragma unroll
            for (int j = 0; j < 4; ++j) { u2[2 * j] = bf_lo(a[j]); u2[2 * j + 1] = bf_hi(a[j]); u1[2 * j] = bf_lo(b[j]); u1[2 * j + 1] = bf_hi(b[j]); } }
#pragma unroll 4
        for (int i = 0; i < RUN; ++i) { const size_t ro = (size_t)(t0 + i) * FF_N + ucol; const u32x4 uu = *(const u32x4*)(ug + ro), gg = *(const u32x4*)(ug + ro + 128);
            float uc[8], gv[8], o[8];
#pragma unroll
            for (int j = 0; j < 4; ++j) { uc[2 * j] = bf_lo(uu[j]); uc[2 * j + 1] = bf_hi(uu[j]); gv[2 * j] = bf_lo(gg[j]); gv[2 * j + 1] = bf_hi(gg[j]); }
#pragma unroll
            for (int j = 0; j < 8; ++j) { const float a = w0[j] * u2[j] + w1[j] * u1[j] + w2[j] * uc[j] + bb[j]; o[j] = a / (1.f + __expf(-a)) * gv[j]; u2[j] = u1[j]; u1[j] = uc[j]; }
            u32x4 w; w.x = pk2(o[0], o[1]); w.y = pk2(o[2], o[3]); w.z = pk2(o[4], o[5]); w.w = pk2(o[6], o[7]);
            *(u32x4*)(act + (size_t)(t0 + i) * DFF + c0) = w; }
    }
}


__device__ __forceinline__ void ffnfix_pm(const Params& p, int layer, int pm) {
    if ((pm & 15) == 0) return;
    const float* cw = p.in[I_FFCONVW] + (size_t)layer * 3 * DFF;
    const float* UH = (const float*)(p.ws + WS_R2); const float* AP = UH + (size_t)128 * 2 * DFF; const float* GP = AP + (size_t)128 * 2 * DFF;
    bf16_t* act = (bf16_t*)(p.ws + WS_R1);
    int tid_ = threadIdx.x; asm volatile("" : "+v"(tid_));
    constexpr int NCH = DFF / 4;
    for (int it = tid_; it < NCH; it += NTHREADS) {
        const int c0 = it * 4;
        const f32x4 w0 = *(const f32x4*)(cw + c0), w1 = *(const f32x4*)(cw + DFF + c0);
        const f32x4 um2 = *(const f32x4*)(UH + ((size_t)(pm - 1) * 2 + 0) * DFF + c0), um1 = *(const f32x4*)(UH + ((size_t)(pm - 1) * 2 + 1) * DFF + c0);
        const f32x4 a0 = *(const f32x4*)(AP + ((size_t)pm * 2 + 0) * DFF + c0) + w0 * um2 + w1 * um1, a1 = *(const f32x4*)(AP + ((size_t)pm * 2 + 1) * DFF + c0) + w0 * um1;
        const f32x4 g0 = *(const f32x4*)(GP + ((size_t)pm * 2 + 0) * DFF + c0), g1 = *(const f32x4*)(GP + ((size_t)pm * 2 + 1) * DFF + c0);
        f32x4 o0, o1;
#pragma unroll
        for (int c = 0; c < 4; ++c) { o0[c] = a0[c] * __builtin_amdgcn_rcpf(1.f + __builtin_amdgcn_exp2f(a0[c] * -1.4426950408889634f)) * g0[c]; o1[c] = a1[c] * __builtin_amdgcn_rcpf(1.f + __builtin_amdgcn_exp2f(a1[c] * -1.4426950408889634f)) * g1[c]; }
        u32x2 w; w.x = pk2(o0[0], o0[1]); w.y = pk2(o0[2], o0[3]); *(u32x2*)(act + (size_t)(pm * 256) * DFF + c0) = w;
        w.x = pk2(o1[0], o1[1]); w.y = pk2(o1[2], o1[3]); *(u32x2*)(act + (size_t)(pm * 256 + 1) * DFF + c0) = w;
    }
}

__device__ __forceinline__ void phase_scan_kmean(const Params& p, unsigned char* lds) {
    int tid_ = threadIdx.x; asm volatile("" : "+v"(tid_)); const int tid = tid_, lane = tid & 63, wave = tid >> 6;
    const float* lf = (const float*)(p.ws + WS_LF); float* F2 = (float*)(p.ws + WS_F2); float* kmean = (float*)(p.ws + WS_KMEAN);
    const bf16_t* Kg = (const bf16_t*)(p.ws + WS_R1) + (size_t)MROWS * DM;
    float* red = (float*)lds; float* redn = red + 1024;
    float* knt = (float*)(p.ws + WS_KNT);
    const int NU = 64 + 2048, G = gridDim.x; const int ch = tid & 7, rg = tid >> 3;
    u32x4 nk[4];
#define KB_LOAD(uu) do { if ((uu) >= 64 && (uu) < NU) { const int k_ = (uu) - 64; const int blk_ = k_ & 15, h_ = (k_ >> 4) & 15, b_ = k_ >> 8; \
        _Pragma("unroll") for (int i = 0; i < 4; ++i) nk[i] = *(const u32x4*)(Kg + ((size_t)b_ * SEQ + blk_ * 256 + rg * 4 + i) * DM + h_ * 64 + ch * 8); } } while (0)
    int u = blockIdx.x;
    KB_LOAD(u);
    for (; u < NU; u += G) {
        __syncthreads();
        if (u < 64) {
            KB_LOAD(u + G);
            const int b = u >> 3, h = u & 7; float v[8]; float s = 0.f;
#pragma unroll
            for (int i = 0; i < 8; ++i) { s += lf[((size_t)b * SEQ + tid * 8 + i) * 8 + h]; v[i] = s; }
            float incl = s;
#pragma unroll
            for (int o = 1; o < 64; o <<= 1) { const float t = __shfl_up(incl, o); if (lane >= o) incl += t; }
            if (lane == 63) red[wave] = incl;
            __syncthreads();
            float off = incl - s;
            for (int w = 0; w < wave; ++w) off += red[w];
#pragma unroll
            for (int i = 0; i < 8; ++i) F2[((size_t)b * 8 + h) * SEQ + tid * 8 + i] = v[i] + off;
        } else {
            const int k = u - 64; const int blk = k & 15, h = (k >> 4) & 15, b = k >> 8;
            u32x4 ck[4];
#pragma unroll
            for (int i = 0; i < 4; ++i) ck[i] = nk[i];
            KB_LOAD(u + G);
            float s[8], mxn = 0.f;
#pragma unroll
            for (int j = 0; j < 8; ++j) s[j] = 0.f;
#pragma unroll
            for (int i = 0; i < 4; ++i) { float sq = 0.f;
#pragma unroll
                for (int j = 0; j < 4; ++j) { const float a = bf_lo(ck[i][j]), c = bf_hi(ck[i][j]); sq += a * a + c * c; s[2 * j] += a; s[2 * j + 1] += c; }
                sq += __shfl_xor(sq, 1); sq += __shfl_xor(sq, 2); sq += __shfl_xor(sq, 4); mxn = fmaxf(mxn, sq); }
            mxn = fmaxf(mxn, __shfl_xor(mxn, 8)); mxn = fmaxf(mxn, __shfl_xor(mxn, 16)); mxn = fmaxf(mxn, __shfl_xor(mxn, 32));
            if (lane == 0) redn[wave] = mxn;
            if (h >= 8) {
#pragma unroll
                for (int j = 0; j < 8; ++j) { float t = s[j]; t += __shfl_xor(t, 8); t += __shfl_xor(t, 16); t += __shfl_xor(t, 32); s[j] = t; }
                if (lane < 8) {
#pragma unroll
                    for (int j = 0; j < 8; ++j) red[wave * 64 + lane * 8 + j] = s[j]; }
            }
            __syncthreads();
            if (tid < 4) knt[((size_t)b * 16 + h) * 64 + blk * 4 + tid] = fmaxf(redn[2 * tid], redn[2 * tid + 1]);
            if (h >= 8 && tid < 64) { float t = 0.f;
#pragma unroll
                for (int w = 0; w < 8; ++w) t += red[w * 64 + tid];
                kmean[(((size_t)b * 8 + (h - 8)) * 16 + blk) * 64 + tid] = t * (1.0f / 256.0f); }
        }
    }
#undef KB_LOAD
    __syncthreads();
}

constexpr float NEGBIG = -1.0e30f;
template <bool MOBA>
__device__ __forceinline__ void attn_unit(unsigned char* lds, LAS unsigned char* lds3, const Params& p, int b, int h, int qb) {
    int tid_ = threadIdx.x; asm volatile("" : "+v"(tid_)); const int tid = tid_, lane = tid & 63, w = __builtin_amdgcn_readfirstlane(tid >> 6), fr = lane & 15, fq = lane >> 4;
    const bf16_t* Qg = (const bf16_t*)(p.ws + WS_R1); const bf16_t* Kg = Qg + (size_t)MROWS * DM; const bf16_t* Vg = Kg + (size_t)MROWS * DM;
    bf16_t* Og = (bf16_t*)(p.ws + WS_R2);
    const int hcol = (MOBA ? 8 + h : h) * 64; const size_t rowbase = (size_t)b * SEQ;
    LAS bf16_t* Ks = (LAS bf16_t*)lds3; LAS bf16_t* Vt = (LAS bf16_t*)(lds3 + 36864);
    LAS float* Fs = (LAS float*)(lds3 + 73728); LAS float* kms = Fs; LAS float* tbl = (LAS float*)(lds3 + 73728 + 4096); LAS unsigned* sel = (LAS unsigned*)(lds3 + 73728 + 4096 + 512);
    const int NT = 4 * (qb + 1);
    const int skey = tid >> 3, sch = tid & 7;
    const bf16_t* kp = Kg + (rowbase + skey) * DM + hcol + sch * 8; const bf16_t* vp = Vg + (rowbase + skey) * DM + hcol + sch * 8;
    u32x4 kreg[2], vreg[2];
#pragma unroll
    for (int sb = 0; sb < 2; ++sb) { kreg[sb] = *(const u32x4*)(kp + (size_t)(NT - 1 - sb) * 64 * DM); vreg[sb] = *(const u32x4*)(vp + (size_t)(NT - 1 - sb) * 64 * DM); }
    const size_t qrow0 = rowbase + qb * 256 + 32 * w;
    bf16x8 qf[2][2];
#pragma unroll
    for (int jb = 0; jb < 2; ++jb)
#pragma unroll
        for (int ks = 0; ks < 2; ++ks) qf[jb][ks] = *(const bf16x8*)(Qg + (qrow0 + 16 * jb + fr) * DM + hcol + 32 * ks + 8 * fq);
    __syncthreads();
    float c31 = 0.f, bmax = -1.0e30f;
    if (tid < 64) ((LAS float*)(lds3 + 73728 + 16384 + 2048))[64 + tid] = (tid < NT) ? ((const float*)(p.ws + WS_KNT))[((size_t)b * 16 + (MOBA ? 8 + h : h)) * 64 + tid] : 0.f;
    LAS float* kpms = (LAS float*)(lds3 + 73728 + 16384 + 2048);
    volatile LAS unsigned* dflag = (volatile LAS unsigned*)(lds3 + 73728 + 16384 + 2048 + 512);
    if (!MOBA) {
        const float* F2 = (const float*)(p.ws + WS_F2) + ((size_t)b * 8 + h) * SEQ;
        for (int i = tid; i < 256 * (qb + 1); i += NTHREADS) Fs[i] = F2[i];
        if (tid < 16) dflag[tid] = 0u;
    } else {
        const float* km = (const float*)(p.ws + WS_KMEAN) + (((size_t)b * 8 + h) * 16) * 64; const float* relb = p.in[I_RELB];
        for (int i = tid; i < 16 * 64; i += NTHREADS) kms[i] = km[i];
        if (tid < 128) { int bk = tid; if (tid >= 16) { bk = 16 + (int)(logf((float)tid / 16.0f) / 2.0794415416798357f * 16.0f); bk = bk > 31 ? 31 : bk; } tbl[tid] = relb[bk * 8 + h] * LOG2E; }
        c31 = relb[31 * 8 + h] * LOG2E;
        for (int bk = 0; bk < 32; ++bk) bmax = fmaxf(bmax, relb[bk * 8 + h] * LOG2E);
        __syncthreads();
        if (tid < 256) {
            const bf16_t* qp = Qg + (rowbase + qb * 256 + tid) * DM + hcol; float qv[64];
#pragma unroll
            for (int c = 0; c < 8; ++c) { const u32x4 v = *(const u32x4*)(qp + c * 8);
#pragma unroll
                for (int j = 0; j < 4; ++j) { qv[c * 8 + 2 * j] = bf_lo(v[j]); qv[c * 8 + 2 * j + 1] = bf_hi(v[j]); } }
            float v1 = -INFINITY, v2 = -INFINITY, v3 = -INFINITY; int i1 = -1, i2 = -1, i3 = -1;
            for (int j = 0; j < qb; ++j) { float d = 0.f;
#pragma unroll
                for (int c = 0; c < 16; ++c) { const f32x4 kv = *(const LAS f32x4*)(kms + j * 64 + c * 4); d += qv[4 * c] * kv[0] + qv[4 * c + 1] * kv[1] + qv[4 * c + 2] * kv[2] + qv[4 * c + 3] * kv[3]; }
                if (d > v1) { v3 = v2; i3 = i2; v2 = v1; i2 = i1; v1 = d; i1 = j; } else if (d > v2) { v3 = v2; i3 = i2; v2 = d; i2 = j; } else if (d > v3) { v3 = d; i3 = j; } }
            unsigned mask = 0u; if (i1 >= 0) mask |= 1u << i1; if (i2 >= 0) mask |= 1u << i2; if (i3 >= 0) mask |= 1u << i3;
            sel[tid] = mask | (1u << qb);
        }
    }
    const int vswz = (skey ^ (sch << 3));
#define ATT_STORE1(slot, kreg, vreg) do { *(LAS u32x4*)(Ks + (slot) * 4608 + skey * 72 + sch * 8) = kreg; \
        _Pragma("unroll") for (int i_ = 0; i_ < 4; ++i_) { Vt[(slot) * 4608 + (sch * 8 + 2 * i_) * 72 + vswz] = (bf16_t)(vreg[i_] & 0xffffu); Vt[(slot) * 4608 + (sch * 8 + 2 * i_ + 1) * 72 + vswz] = (bf16_t)(vreg[i_] >> 16); } } while (0)
#define ATT_STORE(buf) do { ATT_STORE1((buf) * 2, kreg[0], vreg[0]); ATT_STORE1((buf) * 2 + 1, kreg[1], vreg[1]); } while (0)
    ATT_STORE(0);
    __syncthreads();
    if (tid < 64) { float pm = 0.f; for (int t = 0; t <= tid; ++t) pm = fmaxf(pm, kpms[64 + t]); kpms[tid] = sqrtf(pm) * 1.002f; }
    __syncthreads();
    f32x4 o[4][2];
#pragma unroll
    for (int db = 0; db < 4; ++db) { o[db][0] = (f32x4){0.f, 0.f, 0.f, 0.f}; o[db][1] = (f32x4){0.f, 0.f, 0.f, 0.f}; }
    float lrow[2] = {0.f, 0.f};
    float fq2[2] = {0.f, 0.f}; unsigned selm[2] = {0u, 0u};
    if (!MOBA) { fq2[0] = Fs[qb * 256 + 32 * w + fr]; fq2[1] = Fs[qb * 256 + 32 * w + 16 + fr]; }
    else { selm[0] = sel[32 * w + fr]; selm[1] = sel[32 * w + 16 + fr]; }
    const int qloc = 32 * w + fr;
    float mref[2], fq0 = 0.f; bool wdone = false;
    {
        float sq[2] = {0.f, 0.f};
#pragma unroll
        for (int jb = 0; jb < 2; ++jb)
#pragma unroll
            for (int ks = 0; ks < 2; ++ks) { const u32x4 qv = __builtin_bit_cast(u32x4, qf[jb][ks]);
#pragma unroll
                for (int j = 0; j < 4; ++j) { const float a = bf_lo(qv[j]), c = bf_hi(qv[j]); sq[jb] += a * a + c * c; } }
        const float kall = kpms[NT - 1];
#pragma unroll
        for (int jb = 0; jb < 2; ++jb) { float v = sq[jb]; v += __shfl_xor(v, 16); v += __shfl_xor(v, 32); mref[jb] = sqrtf(v) * 1.002f * kall + (MOBA ? bmax : 0.f); }
        if (!MOBA) fq0 = Fs[qb * 256 + 32 * w];
    }
    LAS unsigned char* listq = (LAS unsigned char*)(lds3 + 80000); LAS unsigned char* cntw = (LAS unsigned char*)(lds3 + 85120); LAS int* njs = (LAS int*)(lds3 + 85248); LAS float* mrefs = (LAS float*)(lds3 + 84096); LAS float* pst = (LAS float*)(lds3 + 93184);
    int qpl[2] = {qloc, qloc + 16}; bool qv[2] = {true, true}; float mrc[2] = {mref[0], mref[1]};
    if (MOBA) {
        for (int i = tid; i < 256 * 68; i += NTHREADS) pst[i] = 0.f;
        if (fq == 0) { mrefs[32 * w + fr] = mref[0]; mrefs[32 * w + 16 + fr] = mref[1]; }
        const unsigned my = sel[32 * w + (lane & 31)];
        for (int j = 0; j < qb; ++j) { const bool bit = (lane < 32) && ((my >> j) & 1u); const unsigned M = (unsigned)__ballot(bit); if (lane == 0) cntw[w * 16 + j] = (unsigned char)__builtin_popcount(M); }
        __syncthreads();
        for (int j = 0; j < qb; ++j) { const bool bit = (lane < 32) && ((my >> j) & 1u); const unsigned M = (unsigned)__ballot(bit);
            int base = 0, tot = 0;
#pragma unroll
            for (int w2 = 0; w2 < 8; ++w2) { const int c = cntw[w2 * 16 + j]; if (w2 < w) base += c; tot += c; }
            if (bit) listq[j * 256 + base + __builtin_popcount(M & ((1u << (lane & 31)) - 1u))] = (unsigned char)(32 * w + (lane & 31));
            if (tid == 0) njs[j] = tot; }
        __syncthreads();
    }
    bf16x8 qn[2][2] = {{qf[0][0], qf[0][1]}, {qf[1][0], qf[1][1]}};
#define ATT_QPREF(jj) do { if (MOBA && (jj) >= 0) { const int nj_ = __builtin_amdgcn_readfirstlane(njs[jj]); if (32 * w < nj_) { \
        _Pragma("unroll") for (int jb = 0; jb < 2; ++jb) { const int slot_ = 32 * w + 16 * jb + fr; const int q_ = (slot_ < nj_) ? (int)listq[(jj) * 256 + slot_] : 0; \
            _Pragma("unroll") for (int ks = 0; ks < 2; ++ks) qn[jb][ks] = *(const bf16x8*)(Qg + (rowbase + qb * 256 + q_) * DM + hcol + 32 * ks + 8 * fq); } } } } while (0)
    for (int st = 0; st < NT / 2; ++st) {
        const int buf = st & 1;
        if (st + 1 < NT / 2) {
#pragma unroll
            for (int sb = 0; sb < 2; ++sb) { const size_t o_ = (size_t)(NT - 1 - (2 * st + 2 + sb)) * 64 * DM; kreg[sb] = *(const u32x4*)(kp + o_); vreg[sb] = *(const u32x4*)(vp + o_); } }
      for (int sub = 0; sub < 2; ++sub) {
        const int it = 2 * st + sub, t = NT - 1 - it, slot = buf * 2 + sub;
        const int tl = t - 4 * qb;
        if (!MOBA && !wdone && (fq0 - Fs[64 * t + 63]) < -136.f) wdone = true;
        bool active = (tl <= (w >> 1)) && !wdone;
        if (MOBA && it == 0) ATT_QPREF(qb - 1);
        if (MOBA && tl < 0) {
            const int j = t >> 2; const int nj = __builtin_amdgcn_readfirstlane(njs[j]);
            active = (32 * w < nj);
            if (active && (t & 3) == 3) {
#pragma unroll
                for (int jb = 0; jb < 2; ++jb) { const int slot = 32 * w + 16 * jb + fr; qv[jb] = slot < nj; const int q = qv[jb] ? (int)listq[j * 256 + slot] : 0; qpl[jb] = q; mrc[jb] = mrefs[q];
#pragma unroll
                    for (int ks = 0; ks < 2; ++ks) qf[jb][ks] = qn[jb][ks]; }
            }
            if ((t & 3) == 3) ATT_QPREF(j - 1);
        }
        if (active) {
            const bool diag = (tl == (w >> 1));
            f32x4 s[4][2];
            bool band = false;
            if (!MOBA) {
                const float f0 = fq2[0] - mref[0], f1 = fq2[1] - mref[1];
#pragma unroll
                for (int kb = 0; kb < 4; ++kb) { const f32x4 fk = *(const LAS f32x4*)(Fs + 64 * t + 16 * kb + 4 * fq); s[kb][0] = f0 - fk; s[kb][1] = f1 - fk; }
            } else {
                band = (t >> 2) >= qb - 1;
                const float cc = band ? 0.f : c31;
                const float c0 = (qv[0] ? cc : NEGBIG) - mrc[0], c1 = (qv[1] ? cc : NEGBIG) - mrc[1];
#pragma unroll
                for (int kb = 0; kb < 4; ++kb) { s[kb][0] = (f32x4){c0, c0, c0, c0}; s[kb][1] = (f32x4){c1, c1, c1, c1}; }
            }
            { bf16x8 kf[4][2];
#pragma unroll
            for (int kb = 0; kb < 4; ++kb)
#pragma unroll
                for (int ks = 0; ks < 2; ++ks) kf[kb][ks] = *(const LAS bf16x8*)(Ks + slot * 4608 + (16 * kb + fr) * 72 + 32 * ks + 8 * fq);
            __builtin_amdgcn_sched_barrier(0);
#pragma unroll
            for (int kb = 0; kb < 4; ++kb)
#pragma unroll
                for (int ks = 0; ks < 2; ++ks) {
                    s[kb][0] = __builtin_amdgcn_mfma_f32_16x16x32_bf16(kf[kb][ks], qf[0][ks], s[kb][0], 0, 0, 0); s[kb][1] = __builtin_amdgcn_mfma_f32_16x16x32_bf16(kf[kb][ks], qf[1][ks], s[kb][1], 0, 0, 0); }
            __builtin_amdgcn_sched_barrier(0); }
            if (MOBA && band) {
                asm volatile("" ::: "memory");
#pragma unroll
                for (int kb = 0; kb < 4; ++kb)
#pragma unroll
                    for (int jb = 0; jb < 2; ++jb)
#pragma unroll
                        for (int r = 0; r < 4; ++r) { int d = (256 * qb + qpl[jb]) - (64 * t + 16 * kb + 4 * fq + r); d = d < 0 ? 0 : (d > 127 ? 127 : d); s[kb][jb][r] += tbl[d]; }
            }
            if (diag) {
                asm volatile("" ::: "memory");
#pragma unroll
                for (int kb = 0; kb < 4; ++kb)
#pragma unroll
                    for (int jb = 0; jb < 2; ++jb)
#pragma unroll
                        for (int r = 0; r < 4; ++r) { if ((64 * tl + 16 * kb + 4 * fq + r) > (MOBA ? qpl[jb] : qloc + 16 * jb)) s[kb][jb][r] = NEGBIG; }
            }
            {
#pragma unroll
            for (int jb = 0; jb < 2; ++jb) { float ls = 0.f;
#pragma unroll
                for (int kb = 0; kb < 4; ++kb)
#pragma unroll
                    for (int r = 0; r < 4; ++r) { const float e = __builtin_amdgcn_exp2f(s[kb][jb][r]); s[kb][jb][r] = e; ls += e; }
                lrow[jb] += ls; }
            { u32x2 vlo[2][4], vhi[2][4];
#pragma unroll
            for (int ks2 = 0; ks2 < 2; ++ks2)
#pragma unroll
                for (int db = 0; db < 4; ++db) { const int d = 32 * (db >> 1) + 8 * (fr >> 2) + 4 * (db & 1) + (fr & 3);        const int kx = (32 * ks2 + 4 * fq) ^ (((d >> 3) & 7) << 3);
                    vlo[ks2][db] = *(const LAS u32x2*)(Vt + slot * 4608 + d * 72 + kx); vhi[ks2][db] = *(const LAS u32x2*)(Vt + slot * 4608 + d * 72 + (kx ^ 16)); }
            bf16x8 pf[2][2];
#pragma unroll
            for (int ks2 = 0; ks2 < 2; ++ks2)
#pragma unroll
                for (int jb = 0; jb < 2; ++jb) { const f32x4 a = s[2 * ks2][jb], c = s[2 * ks2 + 1][jb]; u32x4 pw; pw.x = pk2(a[0], a[1]); pw.y = pk2(a[2], a[3]); pw.z = pk2(c[0], c[1]); pw.w = pk2(c[2], c[3]); pf[ks2][jb] = __builtin_bit_cast(bf16x8, pw); }
            __builtin_amdgcn_sched_barrier(0);
#pragma unroll
            for (int ks2 = 0; ks2 < 2; ++ks2)
#pragma unroll
                for (int db = 0; db < 4; ++db) { u32x4 vv; vv.x = vlo[ks2][db].x; vv.y = vlo[ks2][db].y; vv.z = vhi[ks2][db].x; vv.w = vhi[ks2][db].y; const bf16x8 vf = __builtin_bit_cast(bf16x8, vv);
                    o[db][0] = __builtin_amdgcn_mfma_f32_16x16x32_bf16(vf, pf[ks2][0], o[db][0], 0, 0, 0); o[db][1] = __builtin_amdgcn_mfma_f32_16x16x32_bf16(vf, pf[ks2][1], o[db][1], 0, 0, 0); }
            __builtin_amdgcn_sched_barrier(0); }
            }
        }
        if (MOBA && (t & 3) == 0 && (tl >= 0 || active)) {
#pragma unroll
            for (int jb = 0; jb < 2; ++jb) { float l = lrow[jb]; l += __shfl_xor(l, 16); l += __shfl_xor(l, 32);
                if (qv[jb]) { LAS float* st = pst + qpl[jb] * 68;
#pragma unroll
                    for (int db = 0; db < 4; ++db) { f32x4 ov = o[db][jb]; asm volatile("" : "+v"(ov)); f32x4 v = *(const LAS f32x4*)(st + 32 * (db >> 1) + 8 * fq + 4 * (db & 1)); v += ov; *(LAS f32x4*)(st + 32 * (db >> 1) + 8 * fq + 4 * (db & 1)) = v; }
                    if (fq == 0) st[64] += l; }
#pragma unroll
                for (int db = 0; db < 4; ++db) o[db][jb] = (f32x4){0.f, 0.f, 0.f, 0.f};
                lrow[jb] = 0.f; }
        }
      }
        if (st + 1 < NT / 2) ATT_STORE(buf ^ 1);
        if (!MOBA) { if (lane == 0) dflag[(st & 1) * 8 + w] = wdone ? 1u : 0u; }
        __syncthreads();
        if (!MOBA) { const u32x4 fa = *(const LAS u32x4*)(lds3 + 73728 + 16384 + 2048 + 512 + (st & 1) * 32), fb = *(const LAS u32x4*)(lds3 + 73728 + 16384 + 2048 + 512 + (st & 1) * 32 + 16);
            if ((fa[0] & fa[1] & fa[2] & fa[3] & fb[0] & fb[1] & fb[2] & fb[3]) != 0u) break; }
    }
#undef ATT_STORE
#undef ATT_STORE1
#undef ATT_QPREF
#pragma unroll
    for (int jb = 0; jb < 2; ++jb) { float l = lrow[jb]; l += __shfl_xor(l, 16); l += __shfl_xor(l, 32);
        if (MOBA) { const LAS float* st = pst + (qloc + 16 * jb) * 68; l = st[64];
#pragma unroll
            for (int db = 0; db < 4; ++db) o[db][jb] = *(const LAS f32x4*)(st + 32 * (db >> 1) + 8 * fq + 4 * (db & 1)); }
        const float inv = 1.0f / l;
        bf16_t* op = Og + (qrow0 + 16 * jb + fr) * DM + hcol + 8 * fq;
#pragma unroll
        for (int dp = 0; dp < 2; ++dp) { const f32x4 v0 = o[2 * dp][jb] * inv, v1 = o[2 * dp + 1][jb] * inv; u32x4 wv; wv.x = pk2(v0[0], v0[1]); wv.y = pk2(v0[2], v0[3]); wv.z = pk2(v1[0], v1[1]); wv.w = pk2(v1[2], v1[3]); *(u32x4*)(op + 32 * dp) = wv; } }
}
__device__ __forceinline__ void phase_attn(const Params& p, unsigned char* lds, LAS unsigned char* lds3) {
    for (int u = blockIdx.x; u < 2048; u += gridDim.x) {
        const int bx = u & 255, i = u >> 8; const int wv = (bx & 7) * 32 + (bx >> 3);
        const int combo = wv >> 2, quarter = wv & 3; const int k = i & 3;
        const int b = combo >> 3, h = ((combo & 7) + 2 * k + (i >> 2)) & 7;
        const int qb = (k == 0) ? quarter : (k == 1) ? 15 - quarter : (k == 2) ? 7 - quarter : 8 + quarter;
        if (i < 4) attn_unit<true>(lds, lds3, p, b, h, qb); else attn_unit<false>(lds, lds3, p, b, h, qb);
    }
    __syncthreads();
}

__device__ __forceinline__ void phase_final(const Params& p) {
    int tid_ = threadIdx.x; asm volatile("" : "+v"(tid_)); const int tid = tid_, lane = tid & 63, wave = tid >> 6;
    const int gw = blockIdx.x * NWAVES + wave, NGW = gridDim.x * NWAVES;
    const float* ssq = (const float*)(p.ws + WS_SSQ); const float* g = p.in[I_FING]; float* out = p.out;
    f32x4 gv[4];
#pragma unroll
    for (int j = 0; j < 4; ++j) gv[j] = ((const f32x4*)g)[lane + 64 * j];
    const bf16_t* hb = (const bf16_t*)(p.ws + WS_HB);
    u32x2 nh[4]; f32x4 ns = {0.f, 0.f, 0.f, 0.f};
    if (gw < MROWS) { const u32x2* hr = (const u32x2*)(hb + (size_t)gw * DM) + lane; ns = *(const f32x4*)(ssq + (size_t)gw * 4);
#pragma unroll
        for (int j = 0; j < 4; ++j) nh[j] = hr[64 * j]; }
    for (int m = gw; m < MROWS; m += NGW) {
        u32x2 ch[4]; const f32x4 cs = ns;
#pragma unroll
        for (int j = 0; j < 4; ++j) ch[j] = nh[j];
        if (m + NGW < MROWS) { const u32x2* hr = (const u32x2*)(hb + (size_t)(m + NGW) * DM) + lane; ns = *(const f32x4*)(ssq + (size_t)(m + NGW) * 4);
#pragma unroll
            for (int j = 0; j < 4; ++j) nh[j] = hr[64 * j]; }
        const float rs = __builtin_amdgcn_rsqf(((cs[0] + cs[1]) + (cs[2] + cs[3])) * (1.0f / 1024.0f) + 1e-6f); f32x4* xr = (f32x4*)(out + (size_t)m * DM) + lane;
#pragma unroll
        for (int j = 0; j < 4; ++j) { const u32x2 hv = ch[j]; const f32x4 v = {bf_lo(hv.x), bf_hi(hv.x), bf_lo(hv.y), bf_hi(hv.y)}; xr[64 * j] = v * rs * gv[j]; } }
}

#define XB_TMO      128
#define XB_XCNT(j)  (256  + 64 * (j))
#define XB_XSUB(j)  (1280 + 64 * (j))
#define XB_XGEN(j)  (2304 + 64 * (j))
#define XB_TOP      3328
#define XB_TOPGEN   3392
#define XCD_BAR_WORDS 3456
#define XB_SPIN_CAP (1u << 18)

__device__ __forceinline__ unsigned xb_ld(unsigned* p)              { return __hip_atomic_load(p, __ATOMIC_RELAXED, __HIP_MEMORY_SCOPE_AGENT); }
__device__ __forceinline__ unsigned xb_add(unsigned* p, unsigned v) { return __hip_atomic_fetch_add(p, v, __ATOMIC_RELAXED, __HIP_MEMORY_SCOPE_AGENT); }
__device__ __forceinline__ unsigned xb_xcc_id() { return (unsigned)__builtin_amdgcn_s_getreg((3 << 11) | 20) & 0xFu; }
#define XB_SPIN(cond, bar) do { unsigned _sp = 0; while (cond) { __builtin_amdgcn_s_sleep(1); \
    if ((++_sp & 255u) == 0u) { if (xb_ld(&(bar)[XB_TMO])) break; if (_sp > XB_SPIN_CAP) { atomicAdd(&(bar)[XB_TMO], 1u); break; } } } } while (0)

struct XcdBarrier {
    unsigned* bar; unsigned x;
    volatile LAS unsigned* st;
};

__device__ __forceinline__ XcdBarrier xcd_barrier_post(unsigned* bar, volatile LAS unsigned* st) {
    XcdBarrier b; b.bar = bar; b.x = xb_xcc_id(); b.st = st;
    if (threadIdx.x == 0) (void)xb_add(&bar[XB_XCNT(b.x)], 1u);
    return b;
}
__device__ __forceinline__ void xcd_barrier_complete(unsigned* bar, unsigned x, unsigned& nloc, unsigned& nx) {
    const unsigned G = gridDim.x * gridDim.y * gridDim.z;
    unsigned sum, cnt, mine, sp = 0u;
    for (;;) {
        sum = 0u; cnt = 0u; mine = 0u;
#pragma unroll
        for (unsigned j = 0; j < 16; ++j) { const unsigned c = xb_ld(&bar[XB_XCNT(j)]); sum += c; cnt += (c > 0u) ? 1u : 0u; mine = (j == x) ? c : mine; }
        if (sum == G) break;
        __builtin_amdgcn_s_sleep(1);
        if ((++sp & 255u) == 0u) { if (xb_ld(&bar[XB_TMO])) break; if (sp > XB_SPIN_CAP) { atomicAdd(&bar[XB_TMO], 1u); break; } }
    }
    nloc = mine > 0u ? mine : 1u; nx = cnt > 0u ? cnt : 1u;
}

__device__ __forceinline__ void xcd_barrier(const XcdBarrier& b) {
    asm volatile("s_waitcnt vmcnt(0)" ::: "memory");
    __syncthreads();
    if (threadIdx.x == 0) {
        unsigned* bar = b.bar;
        __builtin_amdgcn_s_waitcnt(0);
        unsigned nloc = b.st[0], nx = b.st[1];
        if (nloc == 0u) { xcd_barrier_complete(bar, b.x, nloc, nx); b.st[0] = nloc; b.st[1] = nx; }
        const unsigned old = xb_add(&bar[XB_XSUB(b.x)], 1u);
        const unsigned gen = old / nloc;
        if (old + 1u == (gen + 1u) * nloc) {
            __builtin_amdgcn_fence(__ATOMIC_RELEASE, "agent");
            asm volatile("s_waitcnt vmcnt(0)" ::: "memory");
            const unsigned og = xb_add(&bar[XB_TOP], 1u);
            const unsigned tg = og / nx;
            if (og + 1u == (tg + 1u) * nx) xb_add(&bar[XB_TOPGEN], 1u);
            else XB_SPIN(xb_ld(&bar[XB_TOPGEN]) == tg, bar);
            __builtin_amdgcn_fence(__ATOMIC_ACQUIRE, "agent");
            xb_add(&bar[XB_XGEN(b.x)], 1u);
            asm volatile("s_waitcnt vmcnt(0)" ::: "memory");
        } else {
            XB_SPIN(xb_ld(&bar[XB_XGEN(b.x)]) == gen, bar);
            __builtin_amdgcn_fence(__ATOMIC_ACQUIRE, "agent");
            asm volatile("s_waitcnt vmcnt(0)" ::: "memory");
        }
    }
    __syncthreads();
}

constexpr size_t WS_BAR = 100 * MiB + 512 * 1024;
typedef const Params __attribute__((address_space(4)))* KPtr;
__device__ __forceinline__ Params load_params(KPtr kp) { Params p;
#pragma unroll
    for (int i = 0; i < 17; ++i) p.in[i] = kp->in[i];
    p.out = kp->out; p.ws = kp->ws; p.ph_lo = kp->ph_lo; p.ph_hi = kp->ph_hi; return p; }
__global__ void __launch_bounds__(NTHREADS, 2) fwd_megakernel(Params p_arg) {
    extern __shared__ __attribute__((aligned(16))) unsigned char lds[];
    cg::grid_group grid = cg::this_grid();
    PG8_LAS unsigned char* lds3 = (PG8_LAS unsigned char*)lds;
    const KPtr kp0 = (KPtr)__builtin_amdgcn_kernarg_segment_ptr();
    const int ph_lo = p_arg.ph_lo, ph_hi = p_arg.ph_hi;
    volatile LAS unsigned* bst = (volatile LAS unsigned*)(lds3 + 163776);
    if (threadIdx.x < 2) bst[threadIdx.x] = 0u;
    __syncthreads();
    XcdBarrier xbar; xbar.bar = nullptr; xbar.x = 0; xbar.st = bst;
    int ph = 0;
#define PH_BEGIN if (ph >= ph_lo && ph < ph_hi) { KPtr kp_ = kp0; asm volatile("" : "+s"(kp_)); const Params p = load_params(kp_); unsigned char* ws = p.ws; \
    bf16_t* hb = (bf16_t*)(ws + WS_HB); float* ssq = (float*)(ws + WS_SSQ); bf16_t* R1 = (bf16_t*)(ws + WS_R1); bf16_t* R2 = (bf16_t*)(ws + WS_R2); (void)hb; (void)ssq; (void)R1; (void)R2;
#define PH_END_LOCAL asm volatile("s_waitcnt vmcnt(0)" ::: "memory"); __syncthreads(); }
#define PH_END   if (ph + 1 < ph_hi) { if (ph == 0) { grid.sync(); xbar = xcd_barrier_post((unsigned*)(ws + WS_BAR), bst); } else xcd_barrier(xbar); } } ++ph;
    PH_BEGIN { if (blockIdx.x == 0) { unsigned* bw = (unsigned*)(ws + WS_BAR); for (int i = threadIdx.x; i < XCD_BAR_WORDS; i += NTHREADS) bw[i] = 0u; } phase_prologue(p, lds); } PH_END
    for (int layer = 0; layer < 4; ++layer) {
        const int e = layer >> 1;
        if ((layer & 1) == 0) {
            PH_BEGIN { pg8::Gemm g{hb, (const bf16_t*)(ws + WS_EVIN) + (size_t)e * EV_N * DM, MROWS, EV_N, DM}; pg8::StaticOrder S; S.init(MROWS, EV_N, gridDim.x, blockIdx.x);
                pg8::EpiScaleBf16 E{R1, EV_N, ssq, 0, 0, 0, 1.f, -1, nullptr, nullptr};
                pg8::gemm_phase<pg8::EpiScaleBf16, pg8::StaticOrder, true, true>(lds3, g, S, E); } PH_END
            PH_BEGIN phase_evmix(p, lds, e); PH_END
            PH_BEGIN { pg8::Gemm g{R2, (const bf16_t*)(ws + WS_EVOUT) + (size_t)e * DM * DM, MROWS, DM, DM}; pg8::StaticOrder S; S.init(MROWS, DM, gridDim.x, blockIdx.x);
                pg8::EpiResid E{(layer == 0) ? p.in[I_X] : nullptr, hb, ssq, 0, (PG8_LAS float*)(lds3 + 131072)};
                pg8::gemm_phase<pg8::EpiResid, pg8::StaticOrder, true, true>(lds3, g, S, E); } PH_END
        } else {
            PH_BEGIN { pg8::Gemm g{hb, (const bf16_t*)(ws + WS_ODIN) + (size_t)e * OD_NP * DM, MROWS, OD_NP, DM}; pg8::StaticOrder S; S.init(MROWS, OD_NP, gridDim.x, blockIdx.x);
                pg8::EpiScaleBf16 E{R1, DM, ssq, 0, DM, (size_t)MROWS * DM, 0.125f * LOG2E, 12, (float*)(ws + WS_LF), p.in[I_ODBF] + e * 8};
                pg8::gemm_phase<pg8::EpiScaleBf16, pg8::StaticOrder, true, true>(lds3, g, S, E); } PH_END
            PH_BEGIN phase_scan_kmean(p, lds); PH_END
            PH_BEGIN phase_attn(p, lds, lds3); PH_END
            PH_BEGIN { pg8::Gemm g{R2, (const bf16_t*)(ws + WS_ODOUT) + (size_t)e * DM * DM, MROWS, DM, DM}; pg8::StaticOrder S; S.init(MROWS, DM, gridDim.x, blockIdx.x);
                pg8::EpiResid E{(layer == 0) ? p.in[I_X] : nullptr, hb, ssq, 0, (PG8_LAS float*)(lds3 + 131072)};
                pg8::gemm_phase<pg8::EpiResid, pg8::StaticOrder, true, true>(lds3, g, S, E); } PH_END
        }
        PH_BEGIN { pg8::Gemm g{hb, (const bf16_t*)(ws + WS_FFIN) + (size_t)layer * FF_N * DM, MROWS, FF_N, DM}; pg8::StaticOrder S; S.init(MROWS, FF_N, gridDim.x, blockIdx.x);
            float* UH = (float*)(ws + WS_R2);
            pg8::EpiFfnAct E{R1, ssq, p.in[I_FFCONVW] + (size_t)layer * 3 * DFF, p.in[I_FFCONVB] + (size_t)layer * DFF, UH, UH + (size_t)128 * 2 * DFF, UH + (size_t)2 * 128 * 2 * DFF, (PG8_LAS float*)(lds3 + 131072)};
            pg8::gemm_phase<pg8::EpiFfnAct, pg8::StaticOrder, true, true>(lds3, g, S, E); } PH_END
        PH_BEGIN { pg8::StaticOrder S; S.init(MROWS, DM, gridDim.x, blockIdx.x); pg8::Unit fu; int lastpm = -1;
            for (int i = 0; S.next(i, fu); ++i) { if (fu.pm != lastpm) ffnfix_pm(p, layer, fu.pm); lastpm = fu.pm; } } PH_END_LOCAL
        PH_BEGIN { pg8::Gemm g{R1, (const bf16_t*)(ws + WS_FFOUT) + (size_t)layer * DM * DFF, MROWS, DM, DFF}; pg8::StaticOrder S; S.init(MROWS, DM, gridDim.x, blockIdx.x);
            pg8::EpiResid E{nullptr, hb, ssq, 0, (PG8_LAS float*)(lds3 + 131072)};
            pg8::gemm_phase<pg8::EpiResid, pg8::StaticOrder, true, true>(lds3, g, S, E); } PH_END
    }
    PH_BEGIN phase_final(p); PH_END
}
constexpr int N_PHASES = 1 + 2 * (3 + 2) + 2 * (4 + 2) + 1;

#ifndef ONE_LAUNCH
#define ONE_LAUNCH 1
#endif
extern "C" void kernel_launch(void* const* d_in, const int* in_sizes, int n_in, void* d_out, int out_size, void* d_ws, size_t ws_size, hipStream_t stream) {
    static int grid = 0;
    if (grid == 0) {
        if (n_in != 17 || out_size != MROWS * DM || ws_size < WS_END) { fprintf(stderr, "kernel_launch: unexpected shapes (n_in %d out %d ws %zu)\n", n_in, out_size, ws_size); grid = -1; return; }
        int dev = 0, cus = 0, per_cu = 0;
        hipGetDevice(&dev); hipDeviceGetAttribute(&cus, hipDeviceAttributeMultiprocessorCount, dev);
        hipFuncSetAttribute((const void*)fwd_megakernel, hipFuncAttributeMaxDynamicSharedMemorySize, LDS_BYTES);
        hipOccupancyMaxActiveBlocksPerMultiprocessor(&per_cu, (const void*)fwd_megakernel, NTHREADS, LDS_BYTES);
        if (per_cu < 1) { fprintf(stderr, "kernel_launch: occupancy query says %d blocks per CU\n", per_cu); per_cu = 1; }
        (void)hipGetLastError();
        grid = cus;
    }
    if (grid < 0) return;
    Params p{};
    for (int i = 0; i < 17; ++i) p.in[i] = (const float*)d_in[i];
    p.out = (float*)d_out; p.ws = (unsigned char*)d_ws;
#if ONE_LAUNCH
    p.ph_lo = 0; p.ph_hi = N_PHASES;
    void* args[] = {&p};
    hipError_t e = hipLaunchCooperativeKernel((const void*)fwd_megakernel, dim3(grid), dim3(NTHREADS), args, LDS_BYTES, stream);
    if (e != hipSuccess) fprintf(stderr, "cooperative launch failed: %s (grid %d)\n", hipGetErrorString(e), grid);
#else
    for (int ph = 0; ph < N_PHASES; ++ph) { p.ph_lo = ph; p.ph_hi = ph + 1; hipLaunchKernelGGL(fwd_megakernel, dim3(grid), dim3(NTHREADS), LDS_BYTES, stream, p); }
#endif
}
```

```cpp
#include <hip/hip_runtime.h>
#include <hip/hip_cooperative_groups.h>
#include <cstdio>
#include <cstdint>
namespace cg = cooperative_groups;
namespace pg8 {
#define PG8_LAS __attribute__((address_space(3)))
typedef unsigned short bf16_t;
typedef short bf16x8 __attribute__((ext_vector_type(8)));
typedef float f32x4 __attribute__((ext_vector_type(4)));
typedef unsigned u32x4 __attribute__((ext_vector_type(4)));
constexpr int BM = 256, BK = 64, HALF = 128, HTB = HALF * BK * 2  , STAGE_BYTES = 8 * HTB, NXCD = 8, WGM = 8;

__host__ __device__ __forceinline__ int lds_byte(int r, int c) { const int st = (r >> 4) * 2 + (c >> 5), rr = r & 15, cc = c & 31, ob = rr * 64 + cc * 2; return st * 1024 + (ob ^ (((ob >> 9) & 1) << 5)); }
__host__ __device__ __forceinline__ void stage_rc(int b, int& R, int& C) { const int st = b / 1024, sb = b % 1024, swz = sb ^ (((sb >> 9) & 1) << 5); R = (st >> 1) * 16 + swz / 64; C = (st & 1) * 32 + (swz % 64) / 2; }
__host__ __device__ __forceinline__ int perm32(int rho) { const int n = rho >> 4, i = rho & 15; return 8 * (i >> 2) + 4 * n + (i & 3); }

struct Unit { int pm, pn; };
struct Gemm { const bf16_t* A; const bf16_t* Bt; int M, N, K; };

struct StaticOrder {
    int nM, nN, nwg, G, c;
    __host__ __device__ __forceinline__ void init(int M, int N, int G_, int c_) { nM = M / BM; nN = N / BM; nwg = nM * nN; G = G_; c = c_; }
    __host__ __device__ __forceinline__ bool next(int i, Unit& u) const {
        const long L = (long)i * G + c; if (L >= nwg) return false;
        int wgid = (int)L; { const int q = nwg / NXCD, r = nwg % NXCD, xcd = wgid % NXCD, off = wgid / NXCD; wgid = (xcd < r ? xcd * (q + 1) : r * (q + 1) + (xcd - r) * q) + off; }
        const int nig = WGM * nN, gid = wgid / nig, fm = gid * WGM, gsz = (nM - fm) < WGM ? (nM - fm) : WGM;
        u.pm = fm + ((wgid % nig) % gsz); u.pn = (wgid % nig) / gsz; return true;
    }
    __device__ __forceinline__ void a_ready(const Unit&) const {}
    __device__ __forceinline__ void done(const Unit&) const {}
};

__device__ __forceinline__ unsigned cvt_pk_bf16(float lo, float hi) { unsigned r; asm volatile("v_cvt_pk_bf16_f32 %0, %1, %2" : "=v"(r) : "v"(lo), "v"(hi)); return r; }
#ifdef TEST_NORSTD
#define TEST_RS(x) 1.0f
#else
#define TEST_RS(x) (x)
#endif
typedef unsigned u32x2 __attribute__((ext_vector_type(2)));
__device__ __forceinline__ float row_rstd(const float* ssq, int row) {
    const f32x4 a = *(const f32x4*)(ssq + (size_t)row * 4);
    return __builtin_amdgcn_rsqf(((a[0] + a[1]) + (a[2] + a[3])) * (1.0f / 1024.0f) + 1e-6f);
}
struct EpiScaleBf16 {
    static constexpr bool PERM = true, AFTER_DRAIN = false;
    bf16_t* O; int ldc; const float* ssq; int row_off;
    int split_cols; size_t split_stride; float scale0;
    int ftile; float* lf; const float* bfv;
    __device__ __forceinline__ void operator()(const f32x4 (&acc)[2][2][4][2], const Unit& u, int wr, int wc, int fr, int fq) const {
        asm volatile("" : "+v"(fr), "+v"(fq));
        const int row0 = u.pm * BM + wr * 64 + fr;
        if (u.pn == ftile) {
            if (wc == 0 && fq == 0) {
                f32x4 b0 = *(const f32x4*)(bfv), b1 = *(const f32x4*)(bfv + 4);
#pragma unroll
                for (int ai = 0; ai < 2; ++ai)
#pragma unroll
                    for (int m = 0; m < 4; ++m) { const int row = row0 + ai * HALF + m * 16 + row_off; const float rs = row_rstd(ssq, row);
                        f32x4 v0 = acc[ai][0][m][0] * rs + b0, v1 = acc[ai][0][m][1] * rs + b1; f32x4 o0, o1;
#pragma unroll
                        for (int c = 0; c < 4; ++c) { float x = v0[c] * 1.4426950408889634f; o0[c] = fminf(x, 0.f) - __builtin_amdgcn_logf(1.f + __builtin_amdgcn_exp2f(-fabsf(x))); x = v1[c] * 1.4426950408889634f; o1[c] = fminf(x, 0.f) - __builtin_amdgcn_logf(1.f + __builtin_amdgcn_exp2f(-fabsf(x))); }
                        *(f32x4*)(lf + (size_t)row * 8) = o0; *(f32x4*)(lf + (size_t)row * 8 + 4) = o1; asm volatile("" ::: "memory"); }
            }
            return;
        }
        int colt = u.pn * BM; bf16_t* base = O; float sc = 1.f;
        if (split_cols) { const int t = colt / split_cols; base += (size_t)t * split_stride; colt -= t * split_cols; if (t == 0) sc = scale0; }
        const int col0 = colt + wc * 32 + 8 * fq;
        float rsv[2][4];
#pragma unroll
        for (int ai = 0; ai < 2; ++ai)
#pragma unroll
            for (int m = 0; m < 4; ++m) rsv[ai][m] = row_rstd(ssq, row0 + ai * HALF + m * 16 + row_off) * sc;
#pragma unroll
        for (int ai = 0; ai < 2; ++ai)
#pragma unroll
            for (int m = 0; m < 4; ++m) { const int row = row0 + ai * HALF + m * 16; const float rs = rsv[ai][m]; bf16_t* rowp = base + (size_t)row * ldc + col0;
#pragma unroll
                for (int bj = 0; bj < 2; ++bj) { const f32x4 v0 = acc[ai][bj][m][0] * rs, v1 = acc[ai][bj][m][1] * rs;
                    u32x4 w; w.x = cvt_pk_bf16(v0[0], v0[1]); w.y = cvt_pk_bf16(v0[2], v0[3]); w.z = cvt_pk_bf16(v1[0], v1[1]); w.w = cvt_pk_bf16(v1[2], v1[3]);
                    *(u32x4*)(rowp + bj * HALF) = w; } asm volatile("" ::: "memory"); }
    }
};
struct EpiResid {
    static constexpr bool PERM = true, AFTER_DRAIN = false;
    const float* base32; bf16_t* hb; float* ssq; int row_off; PG8_LAS float* P;
    __device__ __forceinline__ void operator()(const f32x4 (&acc)[2][2][4][2], const Unit& u, int wr, int wc, int fr, int fq) const {
        asm volatile("" : "+v"(fr), "+v"(fq));
        const int row0 = row_off + u.pm * BM + wr * 64 + fr, col0 = u.pn * BM + wc * 32 + 8 * fq;
#pragma unroll
        for (int ai = 0; ai < 2; ++ai) {
            u32x4 hv4[4][2];
            if (!base32) {
#pragma unroll
                for (int m = 0; m < 4; ++m)
#pragma unroll
                    for (int bj = 0; bj < 2; ++bj) hv4[m][bj] = *(const u32x4*)(hb + (size_t)(row0 + ai * HALF + m * 16) * 1024 + col0 + bj * HALF);
            }
#pragma unroll
            for (int m = 0; m < 4; ++m) { const int row = row0 + ai * HALF + m * 16; const size_t off = (size_t)row * 1024 + col0; float s = 0.f;
#pragma unroll
                for (int bj = 0; bj < 2; ++bj) { f32x4 b0, b1;
                    if (base32) { b0 = *(const f32x4*)(base32 + off + bj * HALF); b1 = *(const f32x4*)(base32 + off + bj * HALF + 4); }
                    else { const u32x4 hv = hv4[m][bj];
                        b0 = (f32x4){__builtin_bit_cast(float, hv.x << 16), __builtin_bit_cast(float, hv.x & 0xffff0000u), __builtin_bit_cast(float, hv.y << 16), __builtin_bit_cast(float, hv.y & 0xffff0000u)};
                        b1 = (f32x4){__builtin_bit_cast(float, hv.z << 16), __builtin_bit_cast(float, hv.z & 0xffff0000u), __builtin_bit_cast(float, hv.w << 16), __builtin_bit_cast(float, hv.w & 0xffff0000u)}; }
                    const f32x4 o0 = b0 + acc[ai][bj][m][0], o1 = b1 + acc[ai][bj][m][1];
                    s += ((o0[0] * o0[0] + o0[1] * o0[1]) + (o0[2] * o0[2] + o0[3] * o0[3])) + ((o1[0] * o1[0] + o1[1] * o1[1]) + (o1[2] * o1[2] + o1[3] * o1[3]));
                    u32x4 w; w.x = cvt_pk_bf16(o0[0], o0[1]); w.y = cvt_pk_bf16(o0[2], o0[3]); w.z = cvt_pk_bf16(o1[0], o1[1]); w.w = cvt_pk_bf16(o1[2], o1[3]); *(u32x4*)(hb + off + bj * HALF) = w; }
                s += __shfl_xor(s, 16); s += __shfl_xor(s, 32);
                if (fq == 0) P[(wr * 64 + ai * HALF + m * 16 + fr) * 4 + wc] = s;
                asm volatile("" ::: "memory"); }
        }
        asm volatile("s_waitcnt lgkmcnt(0)" ::: "memory"); __builtin_amdgcn_s_barrier(); asm volatile("" ::: "memory");
        { const int t = (wr * 4 + wc) * 64 + fq * 16 + fr; if (t < 256) { const f32x4 v = *(const PG8_LAS f32x4*)(P + t * 4); ssq[(size_t)(row_off + u.pm * BM + t) * 4 + u.pn] = (v[0] + v[1]) + (v[2] + v[3]); } }
    }
};
__device__ __forceinline__ float dpp_shr1(float v) { return __builtin_bit_cast(float, __builtin_amdgcn_update_dpp(0, __builtin_bit_cast(int, v), 0x111, 0xf, 0xf, true)); }
__device__ __forceinline__ float dpp_shr2(float v) { return __builtin_bit_cast(float, __builtin_amdgcn_update_dpp(0, __builtin_bit_cast(int, v), 0x112, 0xf, 0xf, true)); }
__device__ __forceinline__ float dpp_ror1(float v) { return __builtin_bit_cast(float, __builtin_amdgcn_update_dpp(0, __builtin_bit_cast(int, v), 0x121, 0xf, 0xf, false)); }
__device__ __forceinline__ float dpp_shl15(float v) { return __builtin_bit_cast(float, __builtin_amdgcn_update_dpp(0, __builtin_bit_cast(int, v), 0x10F, 0xf, 0xf, true)); }
__device__ __forceinline__ float dpp_shl14(float v) { return __builtin_bit_cast(float, __builtin_amdgcn_update_dpp(0, __builtin_bit_cast(int, v), 0x10E, 0xf, 0xf, true)); }
__device__ __forceinline__ float dpp_ror2(float v) { return __builtin_bit_cast(float, __builtin_amdgcn_update_dpp(0, __builtin_bit_cast(int, v), 0x122, 0xf, 0xf, false)); }
struct EpiFfnAct {
    static constexpr bool PERM = true, AFTER_DRAIN = false;
    bf16_t* act; const float* ssq; const float* cw; const float* cb; float* UH; float* AP; float* GP; PG8_LAS float* X;
    __device__ __forceinline__ void operator()(const f32x4 (&acc)[2][2][4][2], const Unit& u, int wr, int wc, int fr, int fq) const {
        asm volatile("" : "+v"(fr), "+v"(fq));
        constexpr int FF = 2816;
        const int wid = wr * 4 + wc, cl = 32 * wc + 8 * fq, col = u.pn * 128 + cl, row0 = u.pm * BM + wr * 64 + fr;
        const float rs3[2] = {row_rstd(ssq, row0 + 48), row_rstd(ssq, row0 + HALF + 48)};
#pragma unroll
        for (int ai = 0; ai < 2; ++ai) { const float rs = rs3[ai];
            if (fr >= 14) { const f32x4 a = acc[ai][0][3][0] * rs, b = acc[ai][0][3][1] * rs; PG8_LAS f32x4* xp = (PG8_LAS f32x4*)(X + ((wid * 2 + ai) * 2 + (fr - 14)) * 32 + fq * 8); xp[0] = a; xp[1] = b;
                if (wr == 1 && ai == 1) { float* g = UH + ((size_t)u.pm * 2 + (fr - 14)) * FF + col; *(f32x4*)g = a; *(f32x4*)(g + 4) = b; } } }
        asm volatile("s_waitcnt lgkmcnt(0)" ::: "memory"); __builtin_amdgcn_s_barrier(); asm volatile("" ::: "memory");
        const f32x4 w0a = *(const f32x4*)(cw + col), w0b = *(const f32x4*)(cw + col + 4), w1a = *(const f32x4*)(cw + FF + col), w1b = *(const f32x4*)(cw + FF + col + 4);
        const f32x4 w2a = *(const f32x4*)(cw + 2 * FF + col), w2b = *(const f32x4*)(cw + 2 * FF + col + 4), ba = *(const f32x4*)(cb + col), bb = *(const f32x4*)(cb + col + 4);
        const float m0 = (fr == 0) ? 1.f : 0.f, m1 = (fr == 1) ? 1.f : 0.f;
#pragma unroll
        for (int ai = 0; ai < 2; ++ai) {
            f32x4 pa = {0.f, 0.f, 0.f, 0.f}, pb = {0.f, 0.f, 0.f, 0.f};
            float rsv[4];
#pragma unroll
            for (int m = 0; m < 4; ++m) rsv[m] = row_rstd(ssq, row0 + ai * HALF + m * 16);
#pragma unroll
            for (int m = 0; m < 4; ++m) {
                const int row = row0 + ai * HALF + m * 16; const float rs = rsv[m];
                const f32x4 ca = acc[ai][0][m][0] * rs, cb_ = acc[ai][0][m][1] * rs;
                f32x4 aa = w2a * ca + ba, ab = w2b * cb_ + bb;
#pragma unroll
                for (int c = 0; c < 4; ++c) { aa[c] = __builtin_fmaf(w1a[c], dpp_shr1(ca[c]), aa[c]); ab[c] = __builtin_fmaf(w1b[c], dpp_shr1(cb_[c]), ab[c]);
                    aa[c] = __builtin_fmaf(w0a[c], dpp_shr2(ca[c]), aa[c]); ab[c] = __builtin_fmaf(w0b[c], dpp_shr2(cb_[c]), ab[c]); }
                if (m == 0) {
                    if (ai == 1 || wr == 1) { const int sw = ((ai == 1 && wr == 0) ? 4 : 0) + wc, sai = (ai == 1 && wr == 1) ? 1 : 0;
                        const PG8_LAS f32x4* xp = (const PG8_LAS f32x4*)(X + ((sw * 2 + sai) * 2) * 32 + fq * 8); const f32x4 h0a = xp[0], h0b = xp[1], h1a = xp[8], h1b = xp[9];
                        aa += w1a * (h1a * m0) + w0a * (h0a * m0 + h1a * m1); ab += w1b * (h1b * m0) + w0b * (h0b * m0 + h1b * m1); }
                } else {
#pragma unroll
                    for (int c = 0; c < 4; ++c) { aa[c] = __builtin_fmaf(w1a[c], dpp_shl15(pa[c]), aa[c]); ab[c] = __builtin_fmaf(w1b[c], dpp_shl15(pb[c]), ab[c]);
                        aa[c] = __builtin_fmaf(w0a[c], dpp_shl14(pa[c]), aa[c]); ab[c] = __builtin_fmaf(w0b[c], dpp_shl14(pb[c]), ab[c]); }
                }
                const f32x4 ga = acc[ai][1][m][0] * rs, gb = acc[ai][1][m][1] * rs;
                f32x4 ea = aa * -1.4426950408889634f, eb = ab * -1.4426950408889634f;
#pragma unroll
                for (int c = 0; c < 4; ++c) { ea[c] = __builtin_amdgcn_exp2f(ea[c]); eb[c] = __builtin_amdgcn_exp2f(eb[c]); }
                ea = ea + 1.0f; eb = eb + 1.0f;
#pragma unroll
                for (int c = 0; c < 4; ++c) { ea[c] = __builtin_amdgcn_rcpf(ea[c]); eb[c] = __builtin_amdgcn_rcpf(eb[c]); }
                const f32x4 oa = (aa * ga) * ea, ob = (ab * gb) * eb;
                u32x4 w; w.x = cvt_pk_bf16(oa[0], oa[1]); w.y = cvt_pk_bf16(oa[2], oa[3]); w.z = cvt_pk_bf16(ob[0], ob[1]); w.w = cvt_pk_bf16(ob[2], ob[3]);
                *(u32x4*)(act + (size_t)row * FF + col) = w;
                if (m == 0 && ai == 0 && wr == 0 && fr < 2 && (u.pm & 15) != 0) { float* g = AP + ((size_t)u.pm * 2 + fr) * FF + col; *(f32x4*)g = aa; *(f32x4*)(g + 4) = ab;
                    float* g2 = GP + ((size_t)u.pm * 2 + fr) * FF + col; *(f32x4*)g2 = ga; *(f32x4*)(g2 + 4) = gb; }
                pa = ca; pb = cb_;
                asm volatile("" ::: "memory");
            }
        }
    }
};
template <class Epi, class Sched, bool ALIGN_EPI = false, bool SP2 = false>
__device__ __forceinline__ void gemm_phase(PG8_LAS unsigned char* lds, const Gemm g, const Sched& S, const Epi& E) {
    int tid_ = threadIdx.x; asm volatile("" : "+v"(tid_));
    const int tid = tid_, wid = __builtin_amdgcn_readfirstlane(tid >> 6), lane = tid & 63, wr = wid >> 2, wc = wid & 3, fr = lane & 15, fq = lane >> 4;
    const int K = g.K, nt = K / BK;
    unsigned voffA[2], voffB[2];
#pragma unroll
    for (int i = 0; i < 2; ++i) { int R, C; stage_rc(tid * 16 + i * 8192, R, C); const int Rb = Epi::PERM ? ((R & ~31) + perm32(R & 31)) : R;
        voffA[i] = (unsigned)(R * K + C) * 2u; voffB[i] = (unsigned)(Rb * K + C) * 2u; }
    const size_t kstep = (size_t)(BK * 2);
    const size_t hstep = (size_t)HALF * K * 2;
    const size_t tstep = 2 * hstep;
    const unsigned ldsw = (unsigned)wid * 1024u;
    const int aoff = lds_byte(wr * 64 + fr, fq * 8), boff = lds_byte(wc * 32 + fr, fq * 8);
#define PG8_SA(b, h) (((b) * 2 + (h)) * HTB)
#define PG8_SB(b, h) ((4 + (b) * 2 + (h)) * HTB)
#define PG8_STAGE(bufoff, gbase, voff) do { _Pragma("unroll") for (int _i = 0; _i < 2; ++_i) \
        __builtin_amdgcn_global_load_lds((const unsigned*)((const char*)(gbase) + (voff)[_i]), (PG8_LAS unsigned*)(lds + (bufoff) + ldsw + _i * 8192), 16, 0, 0); } while (0)
#define PG8_LDA(dst, b, h) do { _Pragma("unroll") for (int m = 0; m < 4; ++m) _Pragma("unroll") for (int k = 0; k < 2; ++k) dst[m][k] = *(const PG8_LAS bf16x8*)(lds + PG8_SA(b, h) + aoff + m * 2048 + k * 1024); } while (0)
#define PG8_LDB(dst, b, h) do { _Pragma("unroll") for (int n = 0; n < 2; ++n) _Pragma("unroll") for (int k = 0; k < 2; ++k) dst[n][k] = *(const PG8_LAS bf16x8*)(lds + PG8_SB(b, h) + boff + n * 2048 + k * 1024); } while (0)
#define PG8_MMA(ai, bj, At, Bt) do { __builtin_amdgcn_s_setprio(1); _Pragma("unroll") for (int m = 0; m < 4; ++m) _Pragma("unroll") for (int n = 0; n < 2; ++n) _Pragma("unroll") for (int k = 0; k < 2; ++k) \
        acc[ai][bj][m][n] = __builtin_amdgcn_mfma_f32_16x16x32_bf16(Bt[n][k], At[m][k], acc[ai][bj][m][n], 0, 0, 0); __builtin_amdgcn_s_setprio(0); } while (0)
#define PG8_WAIT_V(n) asm volatile("s_waitcnt vmcnt(" #n ")" ::: "memory")
#define PG8_WAIT_L(n) asm volatile("s_waitcnt lgkmcnt(" #n ")" ::: "memory")
#define PG8_BAR __builtin_amdgcn_s_barrier()
#define PG8_SCHED __builtin_amdgcn_sched_barrier(0)
    Unit cur, nxt; int ui = 0;
    if (!S.next(0, cur)) return;
    f32x4 acc[2][2][4][2];
#pragma unroll
    for (int a = 0; a < 2; ++a)
#pragma unroll
        for (int b = 0; b < 2; ++b)
#pragma unroll
            for (int m = 0; m < 4; ++m)
#pragma unroll
                for (int n = 0; n < 2; ++n) acc[a][b][m][n] = (f32x4){0.f, 0.f, 0.f, 0.f};
    bf16x8 At[4][2], B0[2][2], B1[2][2];
    const char* cA = (const char*)g.A + (size_t)cur.pm * tstep; const char* cB = (const char*)g.Bt + (size_t)cur.pn * tstep;
    S.a_ready(cur);
    if constexpr (SP2) {
        PG8_STAGE(PG8_SB(0, 0), cB, voffB); PG8_STAGE(PG8_SB(0, 1), cB + hstep, voffB); PG8_STAGE(PG8_SA(0, 0), cA, voffA); PG8_STAGE(PG8_SA(0, 1), cA + hstep, voffA);
        if (wr == 1) PG8_BAR;
        PG8_WAIT_V(2); PG8_BAR;
        PG8_STAGE(PG8_SB(1, 0), cB + kstep, voffB); PG8_STAGE(PG8_SA(1, 0), cA + kstep, voffA); PG8_STAGE(PG8_SB(1, 1), cB + hstep + kstep, voffB);
        PG8_WAIT_V(6); PG8_BAR;
    } else {
        PG8_STAGE(PG8_SB(0, 0), cB, voffB); PG8_STAGE(PG8_SA(0, 0), cA, voffA); PG8_STAGE(PG8_SB(0, 1), cB + hstep, voffB); PG8_STAGE(PG8_SA(0, 1), cA + hstep, voffA);
        if (wr == 1) PG8_BAR;
        PG8_WAIT_V(4); PG8_BAR;
        PG8_STAGE(PG8_SB(1, 0), cB + kstep, voffB); PG8_STAGE(PG8_SA(1, 0), cA + kstep, voffA); PG8_STAGE(PG8_SB(1, 1), cB + hstep + kstep, voffB);
        PG8_WAIT_V(6); PG8_BAR;
    }
    for (;;) {
        const bool has_next = S.next(ui + 1, nxt);
        const char* nA = has_next ? (const char*)g.A + (size_t)nxt.pm * tstep : cA; const char* nB = has_next ? (const char*)g.Bt + (size_t)nxt.pn * tstep : cB;
        for (int t = 0; t < nt; t += 2) {
            const bool last = (t == nt - 2);
            const char* a1 = cA + (size_t)(t + 1) * kstep;
            const char* a2 = last ? nA : cA + (size_t)(t + 2) * kstep; const char* b2 = last ? nB : cB + (size_t)(t + 2) * kstep;
            const char* a3 = a2 + kstep; const char* b3 = b2 + kstep;
            if (last && has_next) S.a_ready(nxt);
            if constexpr (SP2) {
            PG8_LDB(B0, 0, 0); PG8_LDB(B1, 0, 1); PG8_SCHED; PG8_LDA(At, 0, 0); PG8_STAGE(PG8_SA(1, 1), a1 + hstep, voffA);
            PG8_WAIT_V(8); PG8_WAIT_L(0); PG8_BAR; PG8_MMA(0, 0, At, B0); PG8_MMA(0, 1, At, B1); PG8_BAR; PG8_SCHED;
            PG8_LDA(At, 0, 1); PG8_STAGE(PG8_SB(0, 0), b2, voffB); PG8_STAGE(PG8_SB(0, 1), b2 + hstep, voffB); PG8_STAGE(PG8_SA(0, 0), a2, voffA);
            PG8_WAIT_V(8); PG8_WAIT_L(0); PG8_BAR; PG8_MMA(1, 0, At, B0); PG8_MMA(1, 1, At, B1); PG8_BAR; PG8_SCHED;
            PG8_LDB(B0, 1, 0); PG8_LDB(B1, 1, 1); PG8_SCHED; PG8_LDA(At, 1, 0); PG8_STAGE(PG8_SA(0, 1), a2 + hstep, voffA);
            PG8_WAIT_V(8); PG8_WAIT_L(0); PG8_BAR; PG8_MMA(0, 0, At, B0); PG8_MMA(0, 1, At, B1); PG8_BAR; PG8_SCHED;
            PG8_LDA(At, 1, 1); PG8_STAGE(PG8_SB(1, 0), b3, voffB); PG8_STAGE(PG8_SB(1, 1), b3 + hstep, voffB); PG8_STAGE(PG8_SA(1, 0), a3, voffA);
            PG8_WAIT_V(8); PG8_WAIT_L(0); PG8_BAR; PG8_MMA(1, 0, At, B0); PG8_MMA(1, 1, At, B1); PG8_BAR; PG8_SCHED;
            } else {
            PG8_LDB(B0, 0, 0); PG8_SCHED; PG8_LDA(At, 0, 0); PG8_STAGE(PG8_SA(1, 1), a1 + hstep, voffA);
            PG8_WAIT_L(8); PG8_BAR; PG8_WAIT_L(0); PG8_MMA(0, 0, At, B0); PG8_BAR; PG8_SCHED;
            PG8_LDB(B1, 0, 1); PG8_STAGE(PG8_SB(0, 0), b2, voffB);
            PG8_BAR; PG8_WAIT_L(0); PG8_MMA(0, 1, At, B1); PG8_BAR;
            PG8_LDA(At, 0, 1); PG8_STAGE(PG8_SA(0, 0), a2, voffA);
            PG8_BAR; PG8_WAIT_L(0); PG8_MMA(1, 0, At, B0); PG8_BAR; PG8_SCHED;
            PG8_STAGE(PG8_SB(0, 1), b2 + hstep, voffB);
            PG8_WAIT_V(6); PG8_BAR; PG8_MMA(1, 1, At, B1); PG8_BAR;
            PG8_LDB(B0, 1, 0); PG8_SCHED; PG8_LDA(At, 1, 0); PG8_STAGE(PG8_SA(0, 1), a2 + hstep, voffA);
            PG8_WAIT_L(8); PG8_BAR; PG8_WAIT_L(0); PG8_MMA(0, 0, At, B0); PG8_BAR; PG8_SCHED;
            PG8_LDB(B1, 1, 1); PG8_STAGE(PG8_SB(1, 0), b3, voffB);
            PG8_BAR; PG8_WAIT_L(0); PG8_MMA(0, 1, At, B1); PG8_BAR;
            PG8_LDA(At, 1, 1); PG8_STAGE(PG8_SA(1, 0), a3, voffA);
            PG8_BAR; PG8_WAIT_L(0); PG8_MMA(1, 0, At, B0); PG8_BAR; PG8_SCHED;
            PG8_STAGE(PG8_SB(1, 1), b3 + hstep, voffB);
            PG8_WAIT_V(6); PG8_BAR; PG8_MMA(1, 1, At, B1); PG8_BAR;
            }
        }
        if constexpr (ALIGN_EPI) { if (wr == 0) PG8_BAR; }
        if constexpr (!Epi::AFTER_DRAIN) { E(acc, cur, wr, wc, fr, fq); S.done(cur); }
        if (!has_next) break;
#pragma unroll
        for (int a = 0; a < 2; ++a)
#pragma unroll
            for (int b = 0; b < 2; ++b)
#pragma unroll
                for (int m = 0; m < 4; ++m)
#pragma unroll
                    for (int n = 0; n < 2; ++n) acc[a][b][m][n] = (f32x4){0.f, 0.f, 0.f, 0.f};
        cur = nxt; cA = nA; cB = nB; ++ui;
        if constexpr (ALIGN_EPI) { if (wr == 1) PG8_BAR; }
    }
    PG8_WAIT_V(0);
    if constexpr (!ALIGN_EPI) { if (wr == 0) PG8_BAR; }
    PG8_BAR;
    if constexpr (Epi::AFTER_DRAIN) { E.fused(acc, cur, wr, wc, fr, fq, lds, wid, lane); S.done(cur); }
#undef PG8_SA
#undef PG8_SB
#undef PG8_STAGE
#undef PG8_LDA
#undef PG8_LDB
#undef PG8_MMA
#undef PG8_WAIT_V
#undef PG8_WAIT_L
#undef PG8_BAR
#undef PG8_SCHED
}
}

typedef unsigned short bf16_t;
typedef short bf16x8 __attribute__((ext_vector_type(8)));
typedef float f32x4 __attribute__((ext_vector_type(4)));
typedef unsigned u32x4 __attribute__((ext_vector_type(4)));
typedef unsigned u32x2 __attribute__((ext_vector_type(2)));
#define LAS __attribute__((address_space(3)))
constexpr int MROWS = 32768, DM = 1024, SEQ = 4096, NB = 8, DFF = 2816;
constexpr int EV_N = 2048, OD_N = 3080, OD_NP = 3328, FF_N = 5632;
constexpr float LOG2E = 1.4426950408889634f;
constexpr int NTHREADS = 512, NWAVES = 8;
constexpr int LDS_BYTES = 163840;
constexpr size_t MiB = 1u << 20;
constexpr size_t WS_EVIN = 0, WS_EVOUT = 8 * MiB, WS_ODIN = 12 * MiB, WS_ODOUT = 25 * MiB, WS_FFIN = 29 * MiB, WS_FFOUT = 73 * MiB, WS_POOL = 95 * MiB;
constexpr size_t WS_KNT = 100 * MiB + 768 * 1024;
constexpr size_t WS_SSQ = 96 * MiB, WS_LF = 98 * MiB, WS_F2 = 99 * MiB, WS_KMEAN = 100 * MiB, WS_HB = 101 * MiB, WS_R2 = 165 * MiB, WS_R1 = 253 * MiB, WS_END = 445 * MiB;
constexpr int FF_HALVES = 2, MH = MROWS / FF_HALVES;

struct Params { const float* in[17]; float* out; unsigned char* ws; int ph_lo, ph_hi; };
enum { I_X = 0, I_MIXG, I_FFNG, I_FING, I_EVWIN, I_EVCONV, I_EVPOOLW, I_EVPOOLS, I_EVWOUT, I_ODWIN, I_ODBF, I_ODWOUT, I_RELB, I_FFWIN, I_FFCONVW, I_FFCONVB, I_FFWOUT };

__device__ __forceinline__ unsigned f2bf(float f) { unsigned u = __builtin_bit_cast(unsigned, f); return (u + 0x7fffu + ((u >> 16) & 1u)) >> 16; }
typedef float f32x2_t __attribute__((ext_vector_type(2))); typedef __bf16 bf16x2_t __attribute__((ext_vector_type(2)));
__device__ __forceinline__ unsigned pk2(float lo, float hi) { const f32x2_t v = {lo, hi}; const bf16x2_t b = __builtin_convertvector(v, bf16x2_t); return __builtin_bit_cast(unsigned, b); }
__device__ __forceinline__ float bf_lo(unsigned u) { return __builtin_bit_cast(float, u << 16); }
__device__ __forceinline__ float bf_hi(unsigned u) { return __builtin_bit_cast(float, u & 0xffff0000u); }
__device__ __forceinline__ float wave_sum(float v) {
#pragma unroll
    for (int o = 1; o < 64; o <<= 1) v += __shfl_xor(v, o);
    return v;
}

__device__ __forceinline__ void transpose_item(const float* W, int K, int N, int NP, bf16_t* WT, const float* gvec, int mode, float* scr, int item, int lane) {
    const int nblk = NP / 64, kb = item / nblk, nb = item % nblk, k0 = 64 * kb, n0 = 64 * nb;
    const int nq = 4 * (lane & 15), n = n0 + nq;
#pragma unroll 8
    for (int i = 0; i < 16; ++i) { const int kk = 4 * i + (lane >> 4);
        f32x4 v = {0.f, 0.f, 0.f, 0.f}; if (n < N) v = *(const f32x4*)(W + (size_t)(k0 + kk) * N + n); if (gvec) v = v * gvec[k0 + kk];
        float* d = scr + kk * 65 + nq; d[0] = v[0]; d[1] = v[1]; d[2] = v[2]; d[3] = v[3]; }
    asm volatile("s_waitcnt lgkmcnt(0)" ::: "memory");
    const int c = lane & 7;
#pragma unroll
    for (int j = 0; j < 8; ++j) { const int nl = (lane >> 3) + 8 * j; const float* sp = scr + (8 * c) * 65 + nl; int nn = n0 + nl;
        if (mode == 1) { nn = (nn < DFF) ? ((nn >> 7) * 256 + (nn & 127)) : ((((nn - DFF) >> 7) * 256) + 128 + ((nn - DFF) & 127)); }
        u32x4 o; o.x = pk2(sp[0 * 65], sp[1 * 65]); o.y = pk2(sp[2 * 65], sp[3 * 65]); o.z = pk2(sp[4 * 65], sp[5 * 65]); o.w = pk2(sp[6 * 65], sp[7 * 65]);
        *(u32x4*)(WT + (size_t)nn * K + k0 + 8 * c) = o; }
    asm volatile("s_waitcnt lgkmcnt(0)" ::: "memory");
}
__device__ __forceinline__ void phase_prologue(const Params& p, unsigned char* lds) {
    int tid_ = threadIdx.x; asm volatile("" : "+v"(tid_)); const int tid = tid_, lane = tid & 63, wave = tid >> 6;
    float* scr = (float*)(lds + wave * 16896);
    const int gw = blockIdx.x * NWAVES + wave, NGW = gridDim.x * NWAVES;
    unsigned char* ws = p.ws;
    constexpr int I_EI = 16 * (EV_N / 64), I_EO = 16 * 16, I_OI = 16 * (OD_NP / 64), I_OO = 16 * 16, I_FI = 16 * (FF_N / 64), I_FO = (DFF / 64) * 16, I_PW = 2 * 2;
    constexpr int NITEMS = 2 * I_EI + 2 * I_EO + 2 * I_OI + 2 * I_OO + 4 * I_FI + 4 * I_FO + 8 * I_PW;
    for (int it = gw; it < NITEMS; it += NGW) {
        int r = it;
        if (r < 2 * I_EI) { const int e = r / I_EI; transpose_item(p.in[I_EVWIN] + (size_t)e * DM * EV_N, DM, EV_N, EV_N, (bf16_t*)(ws + WS_EVIN) + (size_t)e * EV_N * DM, p.in[I_MIXG] + (2 * e) * DM, 0, scr, r % I_EI, lane); continue; } r -= 2 * I_EI;
        if (r < 2 * I_EO) { const int e = r / I_EO; transpose_item(p.in[I_EVWOUT] + (size_t)e * DM * DM, DM, DM, DM, (bf16_t*)(ws + WS_EVOUT) + (size_t)e * DM * DM, nullptr, 0, scr, r % I_EO, lane); continue; } r -= 2 * I_EO;
        if (r < 2 * I_OI) { const int e = r / I_OI; transpose_item(p.in[I_ODWIN] + (size_t)e * DM * OD_N, DM, OD_N, OD_NP, (bf16_t*)(ws + WS_ODIN) + (size_t)e * OD_NP * DM, p.in[I_MIXG] + (2 * e + 1) * DM, 0, scr, r % I_OI, lane); continue; } r -= 2 * I_OI;
        if (r < 2 * I_OO) { const int e = r / I_OO; transpose_item(p.in[I_ODWOUT] + (size_t)e * DM * DM, DM, DM, DM, (bf16_t*)(ws + WS_ODOUT) + (size_t)e * DM * DM, nullptr, 0, scr, r % I_OO, lane); continue; } r -= 2 * I_OO;
        if (r < 4 * I_FI) { const int e = r / I_FI; transpose_item(p.in[I_FFWIN] + (size_t)e * DM * FF_N, DM, FF_N, FF_N, (bf16_t*)(ws + WS_FFIN) + (size_t)e * FF_N * DM, p.in[I_FFNG] + e * DM, 1, scr, r % I_FI, lane); continue; } r -= 4 * I_FI;
        if (r < 4 * I_FO) { const int e = r / I_FO; transpose_item(p.in[I_FFWOUT] + (size_t)e * DFF * DM, DFF, DM, DM, (bf16_t*)(ws + WS_FFOUT) + (size_t)e * DM * DFF, nullptr, 0, scr, r % I_FO, lane); continue; } r -= 4 * I_FO;
        { const int e = r / I_PW; transpose_item(p.in[I_EVPOOLW] + (size_t)e * 128 * 128, 128, 128, 128, (bf16_t*)(ws + WS_POOL) + (size_t)e * 128 * 128, nullptr, 0, scr, r % I_PW, lane); }
    }
    const float* x = p.in[I_X]; bf16_t* hb = (bf16_t*)(ws + WS_HB); float* ssq = (float*)(ws + WS_SSQ);
    { f32x4 nv[4];
      if (gw < MROWS) { const f32x4* xr = (const f32x4*)(x + (size_t)gw * DM) + lane;
#pragma unroll
          for (int j = 0; j < 4; ++j) nv[j] = xr[64 * j]; }
      for (int m = gw; m < MROWS; m += NGW) {
        f32x4 v[4]; float s = 0.f;
#pragma unroll
        for (int j = 0; j < 4; ++j) v[j] = nv[j];
        if (m + NGW < MROWS) { const f32x4* xr = (const f32x4*)(x + (size_t)(m + NGW) * DM) + lane;
#pragma unroll
            for (int j = 0; j < 4; ++j) nv[j] = xr[64 * j]; }
#pragma unroll
        for (int j = 0; j < 4; ++j) s += (v[j][0] * v[j][0] + v[j][1] * v[j][1]) + (v[j][2] * v[j][2] + v[j][3] * v[j][3]);
        s = wave_sum(s);
        u32x2* o8 = (u32x2*)(hb + (size_t)m * DM) + lane;
#pragma unroll
        for (int j = 0; j < 4; ++j) { u32x2 w; w.x = pk2(v[j][0], v[j][1]); w.y = pk2(v[j][2], v[j][3]); o8[64 * j] = w; }
        if (lane < 4) ssq[(size_t)m * 4 + lane] = (lane == 0) ? s : 0.f;
      } }
}

__device__ __forceinline__ void phase_evmix(const Params& p, unsigned char* lds, int e) {
    int tid_ = threadIdx.x; asm volatile("" : "+v"(tid_)); const int tid = tid_, lane = tid & 63, wave = tid >> 6, fr = lane & 15, fq = lane >> 4;
    const bf16_t* z = (const bf16_t*)(p.ws + WS_R1); bf16_t* y = (bf16_t*)(p.ws + WS_R2);
    const float* cw = p.in[I_EVCONV] + (size_t)e * 3 * 512; const float* pscale = p.in[I_EVPOOLS] + (size_t)e * 512;
    const bf16_t* poolT = (const bf16_t*)(p.ws + WS_POOL) + (size_t)e * 4 * 128 * 128;
    float* CV = (float*)lds;
    bf16_t* Zp = (bf16_t*)lds;
    bf16_t* Pl = (bf16_t*)(lds + 40960);
    bf16_t* Bl = (bf16_t*)(lds + 77824);
    u32x4 pa[5], pb[5], pg[4];
    const int NU = 256 * 8, G = gridDim.x;
#define EV_LOAD(uu) do { const int part_ = (uu) & 7, t0_ = ((uu) >> 3) * 128, pos0_ = t0_ & (SEQ - 1); \
        if (part_ < 4) { const int cb_ = part_ * 128; \
            _Pragma("unroll") for (int k = 0; k < 5; ++k) { const int it_ = tid + k * NTHREADS; const int r_ = it_ >> 4, ch_ = it_ & 15; pa[k] = (u32x4){0u, 0u, 0u, 0u}; pb[k] = pa[k]; \
                if (it_ < 130 * 16 && pos0_ + r_ - 2 >= 0) { pa[k] = *(const u32x4*)(z + (size_t)(t0_ + r_ - 2) * EV_N + 512 + cb_ + ch_ * 8); pb[k] = *(const u32x4*)(z + (size_t)(t0_ + r_ - 2) * EV_N + 1024 + cb_ + ch_ * 8); } } \
            _Pragma("unroll") for (int k = 0; k < 4; ++k) { const int it_ = tid + k * NTHREADS; pg[k] = *(const u32x4*)(z + (size_t)(t0_ + (it_ >> 4)) * EV_N + cb_ + (it_ & 15) * 8); } \
        } else { const int cb_ = 1536 + (part_ - 4) * 128; \
            _Pragma("unroll") for (int k = 0; k < 5; ++k) { const int it_ = tid + k * NTHREADS; const int r_ = it_ >> 4, ch_ = it_ & 15; pa[k] = (u32x4){0u, 0u, 0u, 0u}; \
                if (it_ < 143 * 16 && pos0_ + r_ - 15 >= 0) pa[k] = *(const u32x4*)(z + (size_t)(t0_ + r_ - 15) * EV_N + cb_ + ch_ * 8); } } } while (0)
    int gl = -1;
    int u = blockIdx.x;
    if (u < NU) EV_LOAD(u);
    for (; u < NU; u += G) {
        const int part = u & 7, rt = u >> 3; const int t0 = rt * 128; const int pos0 = t0 & (SEQ - 1);
        __syncthreads();
        if (part < 4) {
            const int cbase = part * 128, c0 = cbase + (tid & 15) * 8;
            const f32x4 w0a = *(const f32x4*)(cw + c0), w0b = *(const f32x4*)(cw + c0 + 4), w1a = *(const f32x4*)(cw + 512 + c0), w1b = *(const f32x4*)(cw + 512 + c0 + 4), w2a = *(const f32x4*)(cw + 1024 + c0), w2b = *(const f32x4*)(cw + 1024 + c0 + 4);
#pragma unroll
            for (int k = 0; k < 5; ++k) { const int it = tid + k * NTHREADS; if (it < 130 * 16) { const int r = it >> 4, ch = it & 15; const u32x4 gc = pa[k], vv = pb[k];
                const f32x4 a = {bf_lo(gc[0]) * bf_lo(vv[0]), bf_hi(gc[0]) * bf_hi(vv[0]), bf_lo(gc[1]) * bf_lo(vv[1]), bf_hi(gc[1]) * bf_hi(vv[1])};
                const f32x4 b = {bf_lo(gc[2]) * bf_lo(vv[2]), bf_hi(gc[2]) * bf_hi(vv[2]), bf_lo(gc[3]) * bf_lo(vv[3]), bf_hi(gc[3]) * bf_hi(vv[3])};
                *(f32x4*)(CV + r * 128 + ch * 8) = a; *(f32x4*)(CV + r * 128 + ch * 8 + 4) = b; } }
            u32x4 gb[4];
#pragma unroll
            for (int k = 0; k < 4; ++k) gb[k] = pg[k];
            if (u + G < NU) EV_LOAD(u + G);
            __syncthreads();
#pragma unroll
            for (int k = 0; k < 4; ++k) { const int it = tid + k * NTHREADS; const int r = it >> 4;
                const float* cp = CV + r * 128 + (tid & 15) * 8;
                const f32x4 ca = w0a * *(const f32x4*)(cp) + w1a * *(const f32x4*)(cp + 128) + w2a * *(const f32x4*)(cp + 256);
                const f32x4 cb = w0b * *(const f32x4*)(cp + 4) + w1b * *(const f32x4*)(cp + 132) + w2b * *(const f32x4*)(cp + 260);
                const u32x4 g = gb[k]; u32x4 w;
                w.x = pk2(bf_lo(g[0]) * ca[0], bf_hi(g[0]) * ca[1]); w.y = pk2(bf_lo(g[1]) * ca[2], bf_hi(g[1]) * ca[3]); w.z = pk2(bf_lo(g[2]) * cb[0], bf_hi(g[2]) * cb[1]); w.w = pk2(bf_lo(g[3]) * cb[2], bf_hi(g[3]) * cb[3]);
                *(u32x4*)(y + (size_t)(t0 + r) * DM + c0) = w; }
        } else {
            const int g = part - 4, win = 2 << g;
            if (g != gl) {
                const bf16_t* Bt = poolT + (size_t)g * 128 * 128;
#pragma unroll
                for (int k = 0; k < 4; ++k) { const int it = tid + k * NTHREADS; const int n = it >> 4, ch = it & 15; *(u32x4*)(Bl + n * 136 + ch * 8) = *(const u32x4*)(Bt + (size_t)n * 128 + ch * 8); }
                gl = g; }
            f32x4 sc[8];
#pragma unroll
            for (int nb = 0; nb < 8; ++nb) sc[nb] = *(const f32x4*)(pscale + g * 128 + 16 * nb + 4 * fq);
#pragma unroll
            for (int k = 0; k < 5; ++k) { const int it = tid + k * NTHREADS; if (it < 143 * 16) *(u32x4*)(Zp + (it >> 4) * 128 + (it & 15) * 8) = pa[k]; }
            if (u + G < NU) EV_LOAD(u + G);
            __syncthreads();
#pragma unroll
            for (int k = 0; k < 4; ++k) { const int it = tid + k * NTHREADS; const int r = it >> 4, ch = it & 15; const int pos = pos0 + r;
                float sum[8];
#pragma unroll
                for (int j = 0; j < 8; ++j) sum[j] = 0.f;
                for (int i = 0; i < win; ++i) { const u32x4 v = *(const u32x4*)(Zp + (r + 15 - i) * 128 + ch * 8);
#pragma unroll
                    for (int j = 0; j < 4; ++j) { sum[2 * j] += bf_lo(v[j]); sum[2 * j + 1] += bf_hi(v[j]); } }
                const u32x4 xv = *(const u32x4*)(Zp + (r + 15) * 128 + ch * 8); const float inv = 1.0f / (float)((pos + 1 < win) ? pos + 1 : win);
                u32x4 w;
                w.x = pk2(sum[0] * inv - bf_lo(xv[0]), sum[1] * inv - bf_hi(xv[0])); w.y = pk2(sum[2] * inv - bf_lo(xv[1]), sum[3] * inv - bf_hi(xv[1]));
                w.z = pk2(sum[4] * inv - bf_lo(xv[2]), sum[5] * inv - bf_hi(xv[2])); w.w = pk2(sum[6] * inv - bf_lo(xv[3]), sum[7] * inv - bf_hi(xv[3]));
                *(u32x4*)(Pl + r * 136 + ch * 8) = w; }
            __syncthreads();
            f32x4 acc[8];
#pragma unroll
            for (int nb = 0; nb < 8; ++nb) acc[nb] = (f32x4){0.f, 0.f, 0.f, 0.f};
#pragma unroll
            for (int ks = 0; ks < 4; ++ks) { const bf16x8 a = *(const bf16x8*)(Pl + (16 * wave + fr) * 136 + 32 * ks + 8 * fq);
#pragma unroll
                for (int nb = 0; nb < 8; ++nb) { const bf16x8 b = *(const bf16x8*)(Bl + (16 * nb + fr) * 136 + 32 * ks + 8 * fq); acc[nb] = __builtin_amdgcn_mfma_f32_16x16x32_bf16(b, a, acc[nb], 0, 0, 0); } }
            const int row = rt * 128 + 16 * wave + fr;
#pragma unroll
            for (int nb = 0; nb < 8; ++nb) { const int col = g * 128 + 16 * nb + 4 * fq; const f32x4 o = acc[nb] * sc[nb];
                u32x2 w; w.x = pk2(o[0], o[1]); w.y = pk2(o[2], o[3]); *(u32x2*)(y + (size_t)row * DM + 512 + col) = w; }
        }
    }
#undef EV_LOAD
    __syncthreads();
}

__device__ __forceinline__ void phase_ffnact(const Params& p, int layer, const bf16_t* ug, bf16_t* act, int rows) {
    const float* cw = p.in[I_FFCONVW] + (size_t)layer * 3 * DFF; const float* cb = p.in[I_FFCONVB] + (size_t)layer * DFF;
    constexpr int NCH = DFF / 8, RUN = 16;
    const int nitems = (rows / RUN) * NCH;
    int tid_ = threadIdx.x; asm volatile("" : "+v"(tid_));
    for (int it = blockIdx.x * NTHREADS + tid_; it < nitems; it += gridDim.x * NTHREADS) {
        const int ch = it % NCH, rr = it / NCH; const int c0 = ch * 8; const int t0 = rr * RUN, pos0 = t0 & (SEQ - 1);
        const int ucol = (c0 >> 7) * 256 + (c0 & 127);
        float w0[8], w1[8], w2[8], bb[8];
#pragma unroll
        for (int j = 0; j < 8; ++j) { w0[j] = cw[c0 + j]; w1[j] = cw[DFF + c0 + j]; w2[j] = cw[2 * DFF + c0 + j]; bb[j] = cb[c0 + j]; }
        float u1[8], u2[8];
#pragma unroll
        for (int j = 0; j < 8; ++j) { u1[j] = 0.f; u2[j] = 0.f; }
        if (pos0 >= 2) { const u32x4 a = *(const u32x4*)(ug + (size_t)(t0 - 2) * FF_N + ucol), b = *(const u32x4*)(ug + (size_t)(t0 - 1) * FF_N + ucol);
#pragma unroll
            for (int j = 0; j < 4; ++j) { u2[2 * j] = bf_lo(a[j]); u2[2 * j + 1] = bf_hi(a[j]); u1[2 * j] = bf_lo(b[j]); u1[2 * j + 1] = bf_hi(b[j]); } }
#pragma unroll 4
        for (int i = 0; i < RUN; ++i) { const size_t ro = (size_t)(t0 + i) * FF_N + ucol; const u32x4 uu = *(const u32x4*)(ug + ro), gg = *(const u32x4*)(ug + ro + 128);
            float uc[8], gv[8], o[8];
#pragma unroll
            for (int j = 0; j < 4; ++j) { uc[2 * j] = bf_lo(uu[j]); uc[2 * j + 1] = bf_hi(uu[j]); gv[2 * j] = bf_lo(gg[j]); gv[2 * j + 1] = bf_hi(gg[j]); }
#pragma unroll
            for (int j = 0; j < 8; ++j) { const float a = w0[j] * u2[j] + w1[j] * u1[j] + w2[j] * uc[j] + bb[j]; o[j] = a / (1.f + __expf(-a)) * gv[j]; u2[j] = u1[j]; u1[j] = uc[j]; }
            u32x4 w; w.x = pk2(o[0], o[1]); w.y = pk2(o[2], o[3]); w.z = pk2(o[4], o[5]); w.w = pk2(o[6], o[7]);
            *(u32x4*)(act + (size_t)(t0 + i) * DFF + c0) = w; }
    }
}


__device__ __forceinline__ void ffnfix_pm(const Params& p, int layer, int pm) {
    if ((pm & 15) == 0) return;
    const float* cw = p.in[I_FFCONVW] + (size_t)layer * 3 * DFF;
    const float* UH = (const float*)(p.ws + WS_R2); const float* AP = UH + (size_t)128 * 2 * DFF; const float* GP = AP + (size_t)128 * 2 * DFF;
    bf16_t* act = (bf16_t*)(p.ws + WS_R1);
    int tid_ = threadIdx.x; asm volatile("" : "+v"(tid_));
    constexpr int NCH = DFF / 4;
    for (int it = tid_; it < NCH; it += NTHREADS) {
        const int c0 = it * 4;
        const f32x4 w0 = *(const f32x4*)(cw + c0), w1 = *(const f32x4*)(cw + DFF + c0);
        const f32x4 um2 = *(const f32x4*)(UH + ((size_t)(pm - 1) * 2 + 0) * DFF + c0), um1 = *(const f32x4*)(UH + ((size_t)(pm - 1) * 2 + 1) * DFF + c0);
        const f32x4 a0 = *(const f32x4*)(AP + ((size_t)pm * 2 + 0) * DFF + c0) + w0 * um2 + w1 * um1, a1 = *(const f32x4*)(AP + ((size_t)pm * 2 + 1) * DFF + c0) + w0 * um1;
        const f32x4 g0 = *(const f32x4*)(GP + ((size_t)pm * 2 + 0) * DFF + c0), g1 = *(const f32x4*)(GP + ((size_t)pm * 2 + 1) * DFF + c0);
        f32x4 o0, o1;
#pragma unroll
        for (int c = 0; c < 4; ++c) { o0[c] = a0[c] * __builtin_amdgcn_rcpf(1.f + __builtin_amdgcn_exp2f(a0[c] * -1.4426950408889634f)) * g0[c]; o1[c] = a1[c] * __builtin_amdgcn_rcpf(1.f + __builtin_amdgcn_exp2f(a1[c] * -1.4426950408889634f)) * g1[c]; }
        u32x2 w; w.x = pk2(o0[0], o0[1]); w.y = pk2(o0[2], o0[3]); *(u32x2*)(act + (size_t)(pm * 256) * DFF + c0) = w;
        w.x = pk2(o1[0], o1[1]); w.y = pk2(o1[2], o1[3]); *(u32x2*)(act + (size_t)(pm * 256 + 1) * DFF + c0) = w;
    }
}

__device__ __forceinline__ void phase_scan_kmean(const Params& p, unsigned char* lds) {
    int tid_ = threadIdx.x; asm volatile("" : "+v"(tid_)); const int tid = tid_, lane = tid & 63, wave = tid >> 6;
    const float* lf = (const float*)(p.ws + WS_LF); float* F2 = (float*)(p.ws + WS_F2); float* kmean = (float*)(p.ws + WS_KMEAN);
    const bf16_t* Kg = (const bf16_t*)(p.ws + WS_R1) + (size_t)MROWS * DM;
    float* red = (float*)lds; float* redn = red + 1024;
    float* knt = (float*)(p.ws + WS_KNT);
    const int NU = 64 + 2048, G = gridDim.x; const int ch = tid & 7, rg = tid >> 3;
    u32x4 nk[4];
#define KB_LOAD(uu) do { if ((uu) >= 64 && (uu) < NU) { const int k_ = (uu) - 64; const int blk_ = k_ & 15, h_ = (k_ >> 4) & 15, b_ = k_ >> 8; \
        _Pragma("unroll") for (int i = 0; i < 4; ++i) nk[i] = *(const u32x4*)(Kg + ((size_t)b_ * SEQ + blk_ * 256 + rg * 4 + i) * DM + h_ * 64 + ch * 8); } } while (0)
    int u = blockIdx.x;
    KB_LOAD(u);
    for (; u < NU; u += G) {
        __syncthreads();
        if (u < 64) {
            KB_LOAD(u + G);
            const int b = u >> 3, h = u & 7; float v[8]; float s = 0.f;
#pragma unroll
            for (int i = 0; i < 8; ++i) { s += lf[((size_t)b * SEQ + tid * 8 + i) * 8 + h]; v[i] = s; }
            float incl = s;
#pragma unroll
            for (int o = 1; o < 64; o <<= 1) { const float t = __shfl_up(incl, o); if (lane >= o) incl += t; }
            if (lane == 63) red[wave] = incl;
            __syncthreads();
            float off = incl - s;
            for (int w = 0; w < wave; ++w) off += red[w];
#pragma unroll
            for (int i = 0; i < 8; ++i) F2[((size_t)b * 8 + h) * SEQ + tid * 8 + i] = v[i] + off;
        } else {
            const int k = u - 64; const int blk = k & 15, h = (k >> 4) & 15, b = k >> 8;
            u32x4 ck[4];
#pragma unroll
            for (int i = 0; i < 4; ++i) ck[i] = nk[i];
            KB_LOAD(u + G);
            float s[8], mxn = 0.f;
#pragma unroll
            for (int j = 0; j < 8; ++j) s[j] = 0.f;
#pragma unroll
            for (int i = 0; i < 4; ++i) { float sq = 0.f;
#pragma unroll
                for (int j = 0; j < 4; ++j) { const float a = bf_lo(ck[i][j]), c = bf_hi(ck[i][j]); sq += a * a + c * c; s[2 * j] += a; s[2 * j + 1] += c; }
                sq += __shfl_xor(sq, 1); sq += __shfl_xor(sq, 2); sq += __shfl_xor(sq, 4); mxn = fmaxf(mxn, sq); }
            mxn = fmaxf(mxn, __shfl_xor(mxn, 8)); mxn = fmaxf(mxn, __shfl_xor(mxn, 16)); mxn = fmaxf(mxn, __shfl_xor(mxn, 32));
            if (lane == 0) redn[wave] = mxn;
            if (h >= 8) {
#pragma unroll
                for (int j = 0; j < 8; ++j) { float t = s[j]; t += __shfl_xor(t, 8); t += __shfl_xor(t, 16); t += __shfl_xor(t, 32); s[j] = t; }
                if (lane < 8) {
#pragma unroll
                    for (int j = 0; j < 8; ++j) red[wave * 64 + lane * 8 + j] = s[j]; }
            }
            __syncthreads();
            if (tid < 4) knt[((size_t)b * 16 + h) * 64 + blk * 4 + tid] = fmaxf(redn[2 * tid], redn[2 * tid + 1]);
            if (h >= 8 && tid < 64) { float t = 0.f;
#pragma unroll
                for (int w = 0; w < 8; ++w) t += red[w * 64 + tid];
                kmean[(((size_t)b * 8 + (h - 8)) * 16 + blk) * 64 + tid] = t * (1.0f / 256.0f); }
        }
    }
#undef KB_LOAD
    __syncthreads();
}

constexpr float NEGBIG = -1.0e30f;
template <bool MOBA>
__device__ __forceinline__ void attn_unit(unsigned char* lds, LAS unsigned char* lds3, const Params& p, int b, int h, int qb) {
    int tid_ = threadIdx.x; asm volatile("" : "+v"(tid_)); const int tid = tid_, lane = tid & 63, w = __builtin_amdgcn_readfirstlane(tid >> 6), fr = lane & 15, fq = lane >> 4;
    const bf16_t* Qg = (const bf16_t*)(p.ws + WS_R1); const bf16_t* Kg = Qg + (size_t)MROWS * DM; const bf16_t* Vg = Kg + (size_t)MROWS * DM;
    bf16_t* Og = (bf16_t*)(p.ws + WS_R2);
    const int hcol = (MOBA ? 8 + h : h) * 64; const size_t rowbase = (size_t)b * SEQ;
    LAS bf16_t* Ks = (LAS bf16_t*)lds3; LAS bf16_t* Vt = (LAS bf16_t*)(lds3 + 36864);
    LAS float* Fs = (LAS float*)(lds3 + 73728); LAS float* kms = Fs; LAS float* tbl = (LAS float*)(lds3 + 73728 + 4096); LAS unsigned* sel = (LAS unsigned*)(lds3 + 73728 + 4096 + 512);
    const int NT = 4 * (qb + 1);
    const int skey = tid >> 3, sch = tid & 7;
    const bf16_t* kp = Kg + (rowbase + skey) * DM + hcol + sch * 8; const bf16_t* vp = Vg + (rowbase + skey) * DM + hcol + sch * 8;
    u32x4 kreg[2], vreg[2];
#pragma unroll
    for (int sb = 0; sb < 2; ++sb) { kreg[sb] = *(const u32x4*)(kp + (size_t)(NT - 1 - sb) * 64 * DM); vreg[sb] = *(const u32x4*)(vp + (size_t)(NT - 1 - sb) * 64 * DM); }
    const size_t qrow0 = rowbase + qb * 256 + 32 * w;
    bf16x8 qf[2][2];
#pragma unroll
    for (int jb = 0; jb < 2; ++jb)
#pragma unroll
        for (int ks = 0; ks < 2; ++ks) qf[jb][ks] = *(const bf16x8*)(Qg + (qrow0 + 16 * jb + fr) * DM + hcol + 32 * ks + 8 * fq);
    __syncthreads();
    float c31 = 0.f, bmax = -1.0e30f;
    if (tid < 64) ((LAS float*)(lds3 + 73728 + 16384 + 2048))[64 + tid] = (tid < NT) ? ((const float*)(p.ws + WS_KNT))[((size_t)b * 16 + (MOBA ? 8 + h : h)) * 64 + tid] : 0.f;
    LAS float* kpms = (LAS float*)(lds3 + 73728 + 16384 + 2048);
    volatile LAS unsigned* dflag = (volatile LAS unsigned*)(lds3 + 73728 + 16384 + 2048 + 512);
    if (!MOBA) {
        const float* F2 = (const float*)(p.ws + WS_F2) + ((size_t)b * 8 + h) * SEQ;
        for (int i = tid; i < 256 * (qb + 1); i += NTHREADS) Fs[i] = F2[i];
        if (tid < 16) dflag[tid] = 0u;
    } else {
        const float* km = (const float*)(p.ws + WS_KMEAN) + (((size_t)b * 8 + h) * 16) * 64; const float* relb = p.in[I_RELB];
        for (int i = tid; i < 16 * 64; i += NTHREADS) kms[i] = km[i];
        if (tid < 128) { int bk = tid; if (tid >= 16) { bk = 16 + (int)(logf((float)tid / 16.0f) / 2.0794415416798357f * 16.0f); bk = bk > 31 ? 31 : bk; } tbl[tid] = relb[bk * 8 + h] * LOG2E; }
        c31 = relb[31 * 8 + h] * LOG2E;
        for (int bk = 0; bk < 32; ++bk) bmax = fmaxf(bmax, relb[bk * 8 + h] * LOG2E);
        __syncthreads();
        if (tid < 256) {
            const bf16_t* qp = Qg + (rowbase + qb * 256 + tid) * DM + hcol; float qv[64];
#pragma unroll
            for (int c = 0; c < 8; ++c) { const u32x4 v = *(const u32x4*)(qp + c * 8);
#pragma unroll
                for (int j = 0; j < 4; ++j) { qv[c * 8 + 2 * j] = bf_lo(v[j]); qv[c * 8 + 2 * j + 1] = bf_hi(v[j]); } }
            float v1 = -INFINITY, v2 = -INFINITY, v3 = -INFINITY; int i1 = -1, i2 = -1, i3 = -1;
            for (int j = 0; j < qb; ++j) { float d = 0.f;
#pragma unroll
                for (int c = 0; c < 16; ++c) { const f32x4 kv = *(const LAS f32x4*)(kms + j * 64 + c * 4); d += qv[4 * c] * kv[0] + qv[4 * c + 1] * kv[1] + qv[4 * c + 2] * kv[2] + qv[4 * c + 3] * kv[3]; }
                if (d > v1) { v3 = v2; i3 = i2; v2 = v1; i2 = i1; v1 = d; i1 = j; } else if (d > v2) { v3 = v2; i3 = i2; v2 = d; i2 = j; } else if (d > v3) { v3 = d; i3 = j; } }
            unsigned mask = 0u; if (i1 >= 0) mask |= 1u << i1; if (i2 >= 0) mask |= 1u << i2; if (i3 >= 0) mask |= 1u << i3;
            sel[tid] = mask | (1u << qb);
        }
    }
    const int vswz = (skey ^ (sch << 3));
#define ATT_STORE1(slot, kreg, vreg) do { *(LAS u32x4*)(Ks + (slot) * 4608 + skey * 72 + sch * 8) = kreg; \
        _Pragma("unroll") for (int i_ = 0; i_ < 4; ++i_) { Vt[(slot) * 4608 + (sch * 8 + 2 * i_) * 72 + vswz] = (bf16_t)(vreg[i_] & 0xffffu); Vt[(slot) * 4608 + (sch * 8 + 2 * i_ + 1) * 72 + vswz] = (bf16_t)(vreg[i_] >> 16); } } while (0)
#define ATT_STORE(buf) do { ATT_STORE1((buf) * 2, kreg[0], vreg[0]); ATT_STORE1((buf) * 2 + 1, kreg[1], vreg[1]); } while (0)
    ATT_STORE(0);
    __syncthreads();
    if (tid < 64) { float pm = 0.f; for (int t = 0; t <= tid; ++t) pm = fmaxf(pm, kpms[64 + t]); kpms[tid] = sqrtf(pm) * 1.002f; }
    __syncthreads();
    f32x4 o[4][2];
#pragma unroll
    for (int db = 0; db < 4; ++db) { o[db][0] = (f32x4){0.f, 0.f, 0.f, 0.f}; o[db][1] = (f32x4){0.f, 0.f, 0.f, 0.f}; }
    float lrow[2] = {0.f, 0.f};
    float fq2[2] = {0.f, 0.f}; unsigned selm[2] = {0u, 0u};
    if (!MOBA) { fq2[0] = Fs[qb * 256 + 32 * w + fr]; fq2[1] = Fs[qb * 256 + 32 * w + 16 + fr]; }
    else { selm[0] = sel[32 * w + fr]; selm[1] = sel[32 * w + 16 + fr]; }
    const int qloc = 32 * w + fr;
    float mref[2], fq0 = 0.f; bool wdone = false;
    {
        float sq[2] = {0.f, 0.f};
#pragma unroll
        for (int jb = 0; jb < 2; ++jb)
#pragma unroll
            for (int ks = 0; ks < 2; ++ks) { const u32x4 qv = __builtin_bit_cast(u32x4, qf[jb][ks]);
#pragma unroll
                for (int j = 0; j < 4; ++j) { const float a = bf_lo(qv[j]), c = bf_hi(qv[j]); sq[jb] += a * a + c * c; } }
        const float kall = kpms[NT - 1];
#pragma unroll
        for (int jb = 0; jb < 2; ++jb) { float v = sq[jb]; v += __shfl_xor(v, 16); v += __shfl_xor(v, 32); mref[jb] = sqrtf(v) * 1.002f * kall + (MOBA ? bmax : 0.f); }
        if (!MOBA) fq0 = Fs[qb * 256 + 32 * w];
    }
    LAS unsigned char* listq = (LAS unsigned char*)(lds3 + 80000); LAS unsigned char* cntw = (LAS unsigned char*)(lds3 + 85120); LAS int* njs = (LAS int*)(lds3 + 85248); LAS float* mrefs = (LAS float*)(lds3 + 84096); LAS float* pst = (LAS float*)(lds3 + 93184);
    int qpl[2] = {qloc, qloc + 16}; bool qv[2] = {true, true}; float mrc[2] = {mref[0], mref[1]};
    if (MOBA) {
        for (int i = tid; i < 256 * 68; i += NTHREADS) pst[i] = 0.f;
        if (fq == 0) { mrefs[32 * w + fr] = mref[0]; mrefs[32 * w + 16 + fr] = mref[1]; }
        const unsigned my = sel[32 * w + (lane & 31)];
        for (int j = 0; j < qb; ++j) { const bool bit = (lane < 32) && ((my >> j) & 1u); const unsigned M = (unsigned)__ballot(bit); if (lane == 0) cntw[w * 16 + j] = (unsigned char)__builtin_popcount(M); }
        __syncthreads();
        for (int j = 0; j < qb; ++j) { const bool bit = (lane < 32) && ((my >> j) & 1u); const unsigned M = (unsigned)__ballot(bit);
            int base = 0, tot = 0;
#pragma unroll
            for (int w2 = 0; w2 < 8; ++w2) { const int c = cntw[w2 * 16 + j]; if (w2 < w) base += c; tot += c; }
            if (bit) listq[j * 256 + base + __builtin_popcount(M & ((1u << (lane & 31)) - 1u))] = (unsigned char)(32 * w + (lane & 31));
            if (tid == 0) njs[j] = tot; }
        __syncthreads();
    }
    bf16x8 qn[2][2] = {{qf[0][0], qf[0][1]}, {qf[1][0], qf[1][1]}};
#define ATT_QPREF(jj) do { if (MOBA && (jj) >= 0) { const int nj_ = __builtin_amdgcn_readfirstlane(njs[jj]); if (32 * w < nj_) { \
        _Pragma("unroll") for (int jb = 0; jb < 2; ++jb) { const int slot_ = 32 * w + 16 * jb + fr; const int q_ = (slot_ < nj_) ? (int)listq[(jj) * 256 + slot_] : 0; \
            _Pragma("unroll") for (int ks = 0; ks < 2; ++ks) qn[jb][ks] = *(const bf16x8*)(Qg + (rowbase + qb * 256 + q_) * DM + hcol + 32 * ks + 8 * fq); } } } } while (0)
    for (int st = 0; st < NT / 2; ++st) {
        const int buf = st & 1;
        if (st + 1 < NT / 2) {
#pragma unroll
            for (int sb = 0; sb < 2; ++sb) { const size_t o_ = (size_t)(NT - 1 - (2 * st + 2 + sb)) * 64 * DM; kreg[sb] = *(const u32x4*)(kp + o_); vreg[sb] = *(const u32x4*)(vp + o_); } }
      for (int sub = 0; sub < 2; ++sub) {
        const int it = 2 * st + sub, t = NT - 1 - it, slot = buf * 2 + sub;
        const int tl = t - 4 * qb;
        if (!MOBA && !wdone && (fq0 - Fs[64 * t + 63]) < -136.f) wdone = true;
        bool active = (tl <= (w >> 1)) && !wdone;
        if (MOBA && it == 0) ATT_QPREF(qb - 1);
        if (MOBA && tl < 0) {
            const int j = t >> 2; const int nj = __builtin_amdgcn_readfirstlane(njs[j]);
            active = (32 * w < nj);
            if (active && (t & 3) == 3) {
#pragma unroll
                for (int jb = 0; jb < 2; ++jb) { const int slot = 32 * w + 16 * jb + fr; qv[jb] = slot < nj; const int q = qv[jb] ? (int)listq[j * 256 + slot] : 0; qpl[jb] = q; mrc[jb] = mrefs[q];
#pragma unroll
                    for (int ks = 0; ks < 2; ++ks) qf[jb][ks] = qn[jb][ks]; }
            }
            if ((t & 3) == 3) ATT_QPREF(j - 1);
        }
        if (active) {
            const bool diag = (tl == (w >> 1));
            f32x4 s[4][2];
            bool band = false;
            if (!MOBA) {
                const float f0 = fq2[0] - mref[0], f1 = fq2[1] - mref[1];
#pragma unroll
                for (int kb = 0; kb < 4; ++kb) { const f32x4 fk = *(const LAS f32x4*)(Fs + 64 * t + 16 * kb + 4 * fq); s[kb][0] = f0 - fk; s[kb][1] = f1 - fk; }
            } else {
                band = (t >> 2) >= qb - 1;
                const float cc = band ? 0.f : c31;
                const float c0 = (qv[0] ? cc : NEGBIG) - mrc[0], c1 = (qv[1] ? cc : NEGBIG) - mrc[1];
#pragma unroll
                for (int kb = 0; kb < 4; ++kb) { s[kb][0] = (f32x4){c0, c0, c0, c0}; s[kb][1] = (f32x4){c1, c1, c1, c1}; }
            }
            { bf16x8 kf[4][2];
#pragma unroll
            for (int kb = 0; kb < 4; ++kb)
#pragma unroll
                for (int ks = 0; ks < 2; ++ks) kf[kb][ks] = *(const LAS bf16x8*)(Ks + slot * 4608 + (16 * kb + fr) * 72 + 32 * ks + 8 * fq);
            __builtin_amdgcn_sched_barrier(0); __builtin_amdgcn_s_setprio(1);
#pragma unroll
            for (int kb = 0; kb < 4; ++kb)
#pragma unroll
                for (int ks = 0; ks < 2; ++ks) {
                    s[kb][0] = __builtin_amdgcn_mfma_f32_16x16x32_bf16(kf[kb][ks], qf[0][ks], s[kb][0], 0, 0, 0); s[kb][1] = __builtin_amdgcn_mfma_f32_16x16x32_bf16(kf[kb][ks], qf[1][ks], s[kb][1], 0, 0, 0); }
            __builtin_amdgcn_s_setprio(0); __builtin_amdgcn_sched_barrier(0); }
            if (MOBA && band) {
                asm volatile("" ::: "memory");
#pragma unroll
                for (int kb = 0; kb < 4; ++kb)
#pragma unroll
                    for (int jb = 0; jb < 2; ++jb)
#pragma unroll
                        for (int r = 0; r < 4; ++r) { int d = (256 * qb + qpl[jb]) - (64 * t + 16 * kb + 4 * fq + r); d = d < 0 ? 0 : (d > 127 ? 127 : d); s[kb][jb][r] += tbl[d]; }
            }
            if (diag) {
                asm volatile("" ::: "memory");
#pragma unroll
                for (int kb = 0; kb < 4; ++kb)
#pragma unroll
                    for (int jb = 0; jb < 2; ++jb)
#pragma unroll
                        for (int r = 0; r < 4; ++r) { if ((64 * tl + 16 * kb + 4 * fq + r) > (MOBA ? qpl[jb] : qloc + 16 * jb)) s[kb][jb][r] = NEGBIG; }
            }
            {
#pragma unroll
            for (int jb = 0; jb < 2; ++jb) { float ls = 0.f;
#pragma unroll
                for (int kb = 0; kb < 4; ++kb)
#pragma unroll
                    for (int r = 0; r < 4; ++r) { const float e = __builtin_amdgcn_exp2f(s[kb][jb][r]); s[kb][jb][r] = e; ls += e; }
                lrow[jb] += ls; }
            { u32x2 vlo[2][4], vhi[2][4];
#pragma unroll
            for (int ks2 = 0; ks2 < 2; ++ks2)
#pragma unroll
                for (int db = 0; db < 4; ++db) { const int d = 32 * (db >> 1) + 8 * (fr >> 2) + 4 * (db & 1) + (fr & 3);        const int kx = (32 * ks2 + 4 * fq) ^ (((d >> 3) & 7) << 3);
                    vlo[ks2][db] = *(const LAS u32x2*)(Vt + slot * 4608 + d * 72 + kx); vhi[ks2][db] = *(const LAS u32x2*)(Vt + slot * 4608 + d * 72 + (kx ^ 16)); }
            bf16x8 pf[2][2];
#pragma unroll
            for (int ks2 = 0; ks2 < 2; ++ks2)
#pragma unroll
                for (int jb = 0; jb < 2; ++jb) { const f32x4 a = s[2 * ks2][jb], c = s[2 * ks2 + 1][jb]; u32x4 pw; pw.x = pk2(a[0], a[1]); pw.y = pk2(a[2], a[3]); pw.z = pk2(c[0], c[1]); pw.w = pk2(c[2], c[3]); pf[ks2][jb] = __builtin_bit_cast(bf16x8, pw); }
            __builtin_amdgcn_sched_barrier(0); __builtin_amdgcn_s_setprio(1);
#pragma unroll
            for (int ks2 = 0; ks2 < 2; ++ks2)
#pragma unroll
                for (int db = 0; db < 4; ++db) { u32x4 vv; vv.x = vlo[ks2][db].x; vv.y = vlo[ks2][db].y; vv.z = vhi[ks2][db].x; vv.w = vhi[ks2][db].y; const bf16x8 vf = __builtin_bit_cast(bf16x8, vv);
                    o[db][0] = __builtin_amdgcn_mfma_f32_16x16x32_bf16(vf, pf[ks2][0], o[db][0], 0, 0, 0); o[db][1] = __builtin_amdgcn_mfma_f32_16x16x32_bf16(vf, pf[ks2][1], o[db][1], 0, 0, 0); }
            __builtin_amdgcn_s_setprio(0); __builtin_amdgcn_sched_barrier(0); }
            }
        }
        if (MOBA && (t & 3) == 0 && (tl >= 0 || active)) {
#pragma unroll
            for (int jb = 0; jb < 2; ++jb) { float l = lrow[jb]; l += __shfl_xor(l, 16); l += __shfl_xor(l, 32);
                if (qv[jb]) { LAS float* st = pst + qpl[jb] * 68;
#pragma unroll
                    for (int db = 0; db < 4; ++db) { f32x4 ov = o[db][jb]; asm volatile("" : "+v"(ov)); f32x4 v = *(const LAS f32x4*)(st + 32 * (db >> 1) + 8 * fq + 4 * (db & 1)); v += ov; *(LAS f32x4*)(st + 32 * (db >> 1) + 8 * fq + 4 * (db & 1)) = v; }
                    if (fq == 0) st[64] += l; }
#pragma unroll
                for (int db = 0; db < 4; ++db) o[db][jb] = (f32x4){0.f, 0.f, 0.f, 0.f};
                lrow[jb] = 0.f; }
        }
      }
        if (st + 1 < NT / 2) ATT_STORE(buf ^ 1);
        if (!MOBA) { if (lane == 0) dflag[(st & 1) * 8 + w] = wdone ? 1u : 0u; }
        __syncthreads();
        if (!MOBA) { const u32x4 fa = *(const LAS u32x4*)(lds3 + 73728 + 16384 + 2048 + 512 + (st & 1) * 32), fb = *(const LAS u32x4*)(lds3 + 73728 + 16384 + 2048 + 512 + (st & 1) * 32 + 16);
            if ((fa[0] & fa[1] & fa[2] & fa[3] & fb[0] & fb[1] & fb[2] & fb[3]) != 0u) break; }
    }
#undef ATT_STORE
#undef ATT_STORE1
#undef ATT_QPREF
#pragma unroll
    for (int jb = 0; jb < 2; ++jb) { float l = lrow[jb]; l += __shfl_xor(l, 16); l += __shfl_xor(l, 32);
        if (MOBA) { const LAS float* st = pst + (qloc + 16 * jb) * 68; l = st[64];
#pragma unroll
            for (int db = 0; db < 4; ++db) o[db][jb] = *(const LAS f32x4*)(st + 32 * (db >> 1) + 8 * fq + 4 * (db & 1)); }
        const float inv = 1.0f / l;
        bf16_t* op = Og + (qrow0 + 16 * jb + fr) * DM + hcol + 8 * fq;
#pragma unroll
        for (int dp = 0; dp < 2; ++dp) { const f32x4 v0 = o[2 * dp][jb] * inv, v1 = o[2 * dp + 1][jb] * inv; u32x4 wv; wv.x = pk2(v0[0], v0[1]); wv.y = pk2(v0[2], v0[3]); wv.z = pk2(v1[0], v1[1]); wv.w = pk2(v1[2], v1[3]); *(u32x4*)(op + 32 * dp) = wv; } }
}
__device__ __forceinline__ void phase_attn(const Params& p, unsigned char* lds, LAS unsigned char* lds3) {
    for (int u = blockIdx.x; u < 2048; u += gridDim.x) {
        const int bx = u & 255, i = u >> 8; const int wv = (bx & 7) * 32 + (bx >> 3);
        const int combo = wv >> 2, quarter = wv & 3; const int k = i & 3;
        const int b = combo >> 3, h = ((combo & 7) + 2 * k + (i >> 2)) & 7;
        const int qb = (k == 0) ? quarter : (k == 1) ? 15 - quarter : (k == 2) ? 7 - quarter : 8 + quarter;
        if (i < 4) attn_unit<true>(lds, lds3, p, b, h, qb); else attn_unit<false>(lds, lds3, p, b, h, qb);
    }
    __syncthreads();
}

__device__ __forceinline__ void phase_final(const Params& p) {
    int tid_ = threadIdx.x; asm volatile("" : "+v"(tid_)); const int tid = tid_, lane = tid & 63, wave = tid >> 6;
    const int gw = blockIdx.x * NWAVES + wave, NGW = gridDim.x * NWAVES;
    const float* ssq = (const float*)(p.ws + WS_SSQ); const float* g = p.in[I_FING]; float* out = p.out;
    f32x4 gv[4];
#pragma unroll
    for (int j = 0; j < 4; ++j) gv[j] = ((const f32x4*)g)[lane + 64 * j];
    const bf16_t* hb = (const bf16_t*)(p.ws + WS_HB);
    u32x2 nh[4]; f32x4 ns = {0.f, 0.f, 0.f, 0.f};
    if (gw < MROWS) { const u32x2* hr = (const u32x2*)(hb + (size_t)gw * DM) + lane; ns = *(const f32x4*)(ssq + (size_t)gw * 4);
#pragma unroll
        for (int j = 0; j < 4; ++j) nh[j] = hr[64 * j]; }
    for (int m = gw; m < MROWS; m += NGW) {
        u32x2 ch[4]; const f32x4 cs = ns;
#pragma unroll
        for (int j = 0; j < 4; ++j) ch[j] = nh[j];
        if (m + NGW < MROWS) { const u32x2* hr = (const u32x2*)(hb + (size_t)(m + NGW) * DM) + lane; ns = *(const f32x4*)(ssq + (size_t)(m + NGW) * 4);
#pragma unroll
            for (int j = 0; j < 4; ++j) nh[j] = hr[64 * j]; }
        const float rs = __builtin_amdgcn_rsqf(((cs[0] + cs[1]) + (cs[2] + cs[3])) * (1.0f / 1024.0f) + 1e-6f); f32x4* xr = (f32x4*)(out + (size_t)m * DM) + lane;
#pragma unroll
        for (int j = 0; j < 4; ++j) { const u32x2 hv = ch[j]; const f32x4 v = {bf_lo(hv.x), bf_hi(hv.x), bf_lo(hv.y), bf_hi(hv.y)}; xr[64 * j] = v * rs * gv[j]; } }
}

#define XB_TMO      128
#define XB_XCNT(j)  (256  + 64 * (j))
#define XB_XSUB(j)  (1280 + 64 * (j))
#define XB_XGEN(j)  (2304 + 64 * (j))
#define XB_TOP      3328
#define XB_TOPGEN   3392
#define XCD_BAR_WORDS 3456
#define XB_SPIN_CAP (1u << 18)

__device__ __forceinline__ unsigned xb_ld(unsigned* p)              { return __hip_atomic_load(p, __ATOMIC_RELAXED, __HIP_MEMORY_SCOPE_AGENT); }
__device__ __forceinline__ unsigned xb_add(unsigned* p, unsigned v) { return __hip_atomic_fetch_add(p, v, __ATOMIC_RELAXED, __HIP_MEMORY_SCOPE_AGENT); }
__device__ __forceinline__ unsigned xb_xcc_id() { return (unsigned)__builtin_amdgcn_s_getreg((3 << 11) | 20) & 0xFu; }
#define XB_SPIN(cond, bar) do { unsigned _sp = 0; while (cond) { __builtin_amdgcn_s_sleep(1); \
    if ((++_sp & 255u) == 0u) { if (xb_ld(&(bar)[XB_TMO])) break; if (_sp > XB_SPIN_CAP) { atomicAdd(&(bar)[XB_TMO], 1u); break; } } } } while (0)

struct XcdBarrier {
    unsigned* bar; unsigned x;
    volatile LAS unsigned* st;
};

__device__ __forceinline__ XcdBarrier xcd_barrier_post(unsigned* bar, volatile LAS unsigned* st) {
    XcdBarrier b; b.bar = bar; b.x = xb_xcc_id(); b.st = st;
    if (threadIdx.x == 0) (void)xb_add(&bar[XB_XCNT(b.x)], 1u);
    return b;
}
__device__ __forceinline__ void xcd_barrier_complete(unsigned* bar, unsigned x, unsigned& nloc, unsigned& nx) {
    const unsigned G = gridDim.x * gridDim.y * gridDim.z;
    unsigned sum, cnt, mine, sp = 0u;
    for (;;) {
        sum = 0u; cnt = 0u; mine = 0u;
#pragma unroll
        for (unsigned j = 0; j < 16; ++j) { const unsigned c = xb_ld(&bar[XB_XCNT(j)]); sum += c; cnt += (c > 0u) ? 1u : 0u; mine = (j == x) ? c : mine; }
        if (sum == G) break;
        __builtin_amdgcn_s_sleep(1);
        if ((++sp & 255u) == 0u) { if (xb_ld(&bar[XB_TMO])) break; if (sp > XB_SPIN_CAP) { atomicAdd(&bar[XB_TMO], 1u); break; } }
    }
    nloc = mine > 0u ? mine : 1u; nx = cnt > 0u ? cnt : 1u;
}

__device__ __forceinline__ void xcd_barrier(const XcdBarrier& b) {
    asm volatile("s_waitcnt vmcnt(0)" ::: "memory");
    __syncthreads();
    if (threadIdx.x == 0) {
        unsigned* bar = b.bar;
        __builtin_amdgcn_s_waitcnt(0);
        unsigned nloc = b.st[0], nx = b.st[1];
        if (nloc == 0u) { xcd_barrier_complete(bar, b.x, nloc, nx); b.st[0] = nloc; b.st[1] = nx; }
        const unsigned old = xb_add(&bar[XB_XSUB(b.x)], 1u);
        const unsigned gen = old / nloc;
        if (old + 1u == (gen + 1u) * nloc) {
            __builtin_amdgcn_fence(__ATOMIC_RELEASE, "agent");
            asm volatile("s_waitcnt vmcnt(0)" ::: "memory");
            const unsigned og = xb_add(&bar[XB_TOP], 1u);
            const unsigned tg = og / nx;
            if (og + 1u == (tg + 1u) * nx) xb_add(&bar[XB_TOPGEN], 1u);
            else XB_SPIN(xb_ld(&bar[XB_TOPGEN]) == tg, bar);
            __builtin_amdgcn_fence(__ATOMIC_ACQUIRE, "agent");
            xb_add(&bar[XB_XGEN(b.x)], 1u);
            asm volatile("s_waitcnt vmcnt(0)" ::: "memory");
        } else {
            XB_SPIN(xb_ld(&bar[XB_XGEN(b.x)]) == gen, bar);
            __builtin_amdgcn_fence(__ATOMIC_ACQUIRE, "agent");
            asm volatile("s_waitcnt vmcnt(0)" ::: "memory");
        }
    }
    __syncthreads();
}

constexpr size_t WS_BAR = 100 * MiB + 512 * 1024;
typedef const Params __attribute__((address_space(4)))* KPtr;
__device__ __forceinline__ Params load_params(KPtr kp) { Params p;
#pragma unroll
    for (int i = 0; i < 17; ++i) p.in[i] = kp->in[i];
    p.out = kp->out; p.ws = kp->ws; p.ph_lo = kp->ph_lo; p.ph_hi = kp->ph_hi; return p; }
__global__ void __launch_bounds__(NTHREADS, 2) fwd_megakernel(Params p_arg) {
    extern __shared__ __attribute__((aligned(16))) unsigned char lds[];
    cg::grid_group grid = cg::this_grid();
    PG8_LAS unsigned char* lds3 = (PG8_LAS unsigned char*)lds;
    const KPtr kp0 = (KPtr)__builtin_amdgcn_kernarg_segment_ptr();
    const int ph_lo = p_arg.ph_lo, ph_hi = p_arg.ph_hi;
    volatile LAS unsigned* bst = (volatile LAS unsigned*)(lds3 + 163776);
    if (threadIdx.x < 2) bst[threadIdx.x] = 0u;
    __syncthreads();
    XcdBarrier xbar; xbar.bar = nullptr; xbar.x = 0; xbar.st = bst;
    int ph = 0;
#define PH_BEGIN if (ph >= ph_lo && ph < ph_hi) { KPtr kp_ = kp0; asm volatile("" : "+s"(kp_)); const Params p = load_params(kp_); unsigned char* ws = p.ws; \
    bf16_t* hb = (bf16_t*)(ws + WS_HB); float* ssq = (float*)(ws + WS_SSQ); bf16_t* R1 = (bf16_t*)(ws + WS_R1); bf16_t* R2 = (bf16_t*)(ws + WS_R2); (void)hb; (void)ssq; (void)R1; (void)R2;
#define PH_END_LOCAL asm volatile("s_waitcnt vmcnt(0)" ::: "memory"); __syncthreads(); }
#define PH_END   if (ph + 1 < ph_hi) { if (ph == 0) { grid.sync(); xbar = xcd_barrier_post((unsigned*)(ws + WS_BAR), bst); } else xcd_barrier(xbar); } } ++ph;
    PH_BEGIN { if (blockIdx.x == 0) { unsigned* bw = (unsigned*)(ws + WS_BAR); for (int i = threadIdx.x; i < XCD_BAR_WORDS; i += NTHREADS) bw[i] = 0u; } phase_prologue(p, lds); } PH_END
    for (int layer = 0; layer < 4; ++layer) {
        const int e = layer >> 1;
        if ((layer & 1) == 0) {
            PH_BEGIN { pg8::Gemm g{hb, (const bf16_t*)(ws + WS_EVIN) + (size_t)e * EV_N * DM, MROWS, EV_N, DM}; pg8::StaticOrder S; S.init(MROWS, EV_N, gridDim.x, blockIdx.x);
                pg8::EpiScaleBf16 E{R1, EV_N, ssq, 0, 0, 0, 1.f, -1, nullptr, nullptr};
                pg8::gemm_phase<pg8::EpiScaleBf16, pg8::StaticOrder, true, true>(lds3, g, S, E); } PH_END
            PH_BEGIN phase_evmix(p, lds, e); PH_END
            PH_BEGIN { pg8::Gemm g{R2, (const bf16_t*)(ws + WS_EVOUT) + (size_t)e * DM * DM, MROWS, DM, DM}; pg8::StaticOrder S; S.init(MROWS, DM, gridDim.x, blockIdx.x);
                pg8::EpiResid E{(layer == 0) ? p.in[I_X] : nullptr, hb, ssq, 0, (PG8_LAS float*)(lds3 + 131072)};
                pg8::gemm_phase<pg8::EpiResid, pg8::StaticOrder, true, true>(lds3, g, S, E); } PH_END
        } else {
            PH_BEGIN { pg8::Gemm g{hb, (const bf16_t*)(ws + WS_ODIN) + (size_t)e * OD_NP * DM, MROWS, OD_NP, DM}; pg8::StaticOrder S; S.init(MROWS, OD_NP, gridDim.x, blockIdx.x);
                pg8::EpiScaleBf16 E{R1, DM, ssq, 0, DM, (size_t)MROWS * DM, 0.125f * LOG2E, 12, (float*)(ws + WS_LF), p.in[I_ODBF] + e * 8};
                pg8::gemm_phase<pg8::EpiScaleBf16, pg8::StaticOrder, true, true>(lds3, g, S, E); } PH_END
            PH_BEGIN phase_scan_kmean(p, lds); PH_END
            PH_BEGIN phase_attn(p, lds, lds3); PH_END
            PH_BEGIN { pg8::Gemm g{R2, (const bf16_t*)(ws + WS_ODOUT) + (size_t)e * DM * DM, MROWS, DM, DM}; pg8::StaticOrder S; S.init(MROWS, DM, gridDim.x, blockIdx.x);
                pg8::EpiResid E{(layer == 0) ? p.in[I_X] : nullptr, hb, ssq, 0, (PG8_LAS float*)(lds3 + 131072)};
                pg8::gemm_phase<pg8::EpiResid, pg8::StaticOrder, true, true>(lds3, g, S, E); } PH_END
        }
        PH_BEGIN { pg8::Gemm g{hb, (const bf16_t*)(ws + WS_FFIN) + (size_t)layer * FF_N * DM, MROWS, FF_N, DM}; pg8::StaticOrder S; S.init(MROWS, FF_N, gridDim.x, blockIdx.x);
            float* UH = (float*)(ws + WS_R2);
            pg8::EpiFfnAct E{R1, ssq, p.in[I_FFCONVW] + (size_t)layer * 3 * DFF, p.in[I_FFCONVB] + (size_t)layer * DFF, UH, UH + (size_t)128 * 2 * DFF, UH + (size_t)2 * 128 * 2 * DFF, (PG8_LAS float*)(lds3 + 131072)};
            pg8::gemm_phase<pg8::EpiFfnAct, pg8::StaticOrder, true, true>(lds3, g, S, E); } PH_END
        PH_BEGIN { pg8::StaticOrder S; S.init(MROWS, DM, gridDim.x, blockIdx.x); pg8::Unit fu; int lastpm = -1;
            for (int i = 0; S.next(i, fu); ++i) { if (fu.pm != lastpm) ffnfix_pm(p, layer, fu.pm); lastpm = fu.pm; } } PH_END_LOCAL
        PH_BEGIN { pg8::Gemm g{R1, (const bf16_t*)(ws + WS_FFOUT) + (size_t)layer * DM * DFF, MROWS, DM, DFF}; pg8::StaticOrder S; S.init(MROWS, DM, gridDim.x, blockIdx.x);
            pg8::EpiResid E{nullptr, hb, ssq, 0, (PG8_LAS float*)(lds3 + 131072)};
            pg8::gemm_phase<pg8::EpiResid, pg8::StaticOrder, true, true>(lds3, g, S, E); } PH_END
    }
    PH_BEGIN phase_final(p); PH_END
}
constexpr int N_PHASES = 1 + 2 * (3 + 2) + 2 * (4 + 2) + 1;

#ifndef ONE_LAUNCH
#define ONE_LAUNCH 1
#endif
extern "C" void kernel_launch(void* const* d_in, const int* in_sizes, int n_in, void* d_out, int out_size, void* d_ws, size_t ws_size, hipStream_t stream) {
    static int grid = 0;
    if (grid == 0) {
        if (n_in != 17 || out_size != MROWS * DM || ws_size < WS_END) { fprintf(stderr, "kernel_launch: unexpected shapes (n_in %d out %d ws %zu)\n", n_in, out_size, ws_size); grid = -1; return; }
        int dev = 0, cus = 0, per_cu = 0;
        hipGetDevice(&dev); hipDeviceGetAttribute(&cus, hipDeviceAttributeMultiprocessorCount, dev);
        hipFuncSetAttribute((const void*)fwd_megakernel, hipFuncAttributeMaxDynamicSharedMemorySize, LDS_BYTES);
        hipOccupancyMaxActiveBlocksPerMultiprocessor(&per_cu, (const void*)fwd_megakernel, NTHREADS, LDS_BYTES);
        if (per_cu < 1) { fprintf(stderr, "kernel_launch: occupancy query says %d blocks per CU\n", per_cu); per_cu = 1; }
        (void)hipGetLastError();
        grid = cus;
    }
    if (grid < 0) return;
    Params p{};
    for (int i = 0; i < 17; ++i) p.in[i] = (const float*)d_in[i];
    p.out = (float*)d_out; p.ws = (unsigned char*)d_ws;
#if ONE_LAUNCH
    p.ph_lo = 0; p.ph_hi = N_PHASES;
    void* args[] = {&p};
    hipError_t e = hipLaunchCooperativeKernel((const void*)fwd_megakernel, dim3(grid), dim3(NTHREADS), args, LDS_BYTES, stream);
    if (e != hipSuccess) fprintf(stderr, "cooperative launch failed: %s (grid %d)\n", hipGetErrorString(e), grid);
#else
    for (int ph = 0; ph < N_PHASES; ++ph) { p.ph_lo = ph; p.ph_hi = ph + 1; hipLaunchKernelGGL(fwd_megakernel, dim3(grid), dim3(NTHREADS), LDS_BYTES, stream, p); }
#endif
}
```

```cpp
#include <hip/hip_runtime.h>
#include <hip/hip_cooperative_groups.h>
#include <cstdio>
#include <cstdint>
namespace cg = cooperative_groups;
namespace pg8 {
#define PG8_LAS __attribute__((address_space(3)))
typedef unsigned short bf16_t;
typedef short bf16x8 __attribute__((ext_vector_type(8)));
typedef float f32x4 __attribute__((ext_vector_type(4)));
typedef unsigned u32x4 __attribute__((ext_vector_type(4)));
constexpr int BM = 256, BK = 64, HALF = 128, HTB = HALF * BK * 2  , STAGE_BYTES = 8 * HTB, NXCD = 8, WGM = 8;

__host__ __device__ __forceinline__ int lds_byte(int r, int c) { const int st = (r >> 4) * 2 + (c >> 5), rr = r & 15, cc = c & 31, ob = rr * 64 + cc * 2; return st * 1024 + (ob ^ (((ob >> 9) & 1) << 5)); }
__host__ __device__ __forceinline__ void stage_rc(int b, int& R, int& C) { const int st = b / 1024, sb = b % 1024, swz = sb ^ (((sb >> 9) & 1) << 5); R = (st >> 1) * 16 + swz / 64; C = (st & 1) * 32 + (swz % 64) / 2; }
__host__ __device__ __forceinline__ int perm32(int rho) { const int n = rho >> 4, i = rho & 15; return 8 * (i >> 2) + 4 * n + (i & 3); }

struct Unit { int pm, pn; };
struct Gemm { const bf16_t* A; const bf16_t* Bt; int M, N, K; };

struct StaticOrder {
    int nM, nN, nwg, G, c;
    __host__ __device__ __forceinline__ void init(int M, int N, int G_, int c_) { nM = M / BM; nN = N / BM; nwg = nM * nN; G = G_; c = c_; }
    __host__ __device__ __forceinline__ bool next(int i, Unit& u) const {
        const long L = (long)i * G + c; if (L >= nwg) return false;
        int wgid = (int)L; { const int q = nwg / NXCD, r = nwg % NXCD, xcd = wgid % NXCD, off = wgid / NXCD; wgid = (xcd < r ? xcd * (q + 1) : r * (q + 1) + (xcd - r) * q) + off; }
        const int nig = WGM * nN, gid = wgid / nig, fm = gid * WGM, gsz = (nM - fm) < WGM ? (nM - fm) : WGM;
        u.pm = fm + ((wgid % nig) % gsz); u.pn = (wgid % nig) / gsz; return true;
    }
    __device__ __forceinline__ void a_ready(const Unit&) const {}
    __device__ __forceinline__ void done(const Unit&) const {}
};

__device__ __forceinline__ unsigned cvt_pk_bf16(float lo, float hi) { unsigned r; asm volatile("v_cvt_pk_bf16_f32 %0, %1, %2" : "=v"(r) : "v"(lo), "v"(hi)); return r; }
#ifdef TEST_NORSTD
#define TEST_RS(x) 1.0f
#else
#define TEST_RS(x) (x)
#endif
typedef unsigned u32x2 __attribute__((ext_vector_type(2)));
__device__ __forceinline__ float row_rstd(const float* ssq, int row) {
    const f32x4 a = *(const f32x4*)(ssq + (size_t)row * 4);
    return __builtin_amdgcn_rsqf(((a[0] + a[1]) + (a[2] + a[3])) * (1.0f / 1024.0f) + 1e-6f);
}
struct EpiScaleBf16 {
    static constexpr bool PERM = true, AFTER_DRAIN = false;
    bf16_t* O; int ldc; const float* ssq; int row_off;
    int split_cols; size_t split_stride; float scale0;
    int ftile; float* lf; const float* bfv;
    __device__ __forceinline__ void operator()(const f32x4 (&acc)[2][2][4][2], const Unit& u, int wr, int wc, int fr, int fq) const {
        asm volatile("" : "+v"(fr), "+v"(fq));
        const int row0 = u.pm * BM + wr * 64 + fr;
        if (u.pn == ftile) {
            if (wc == 0 && fq == 0) {
                f32x4 b0 = *(const f32x4*)(bfv), b1 = *(const f32x4*)(bfv + 4);
#pragma unroll
                for (int ai = 0; ai < 2; ++ai)
#pragma unroll
                    for (int m = 0; m < 4; ++m) { const int row = row0 + ai * HALF + m * 16 + row_off; const float rs = row_rstd(ssq, row);
                        f32x4 v0 = acc[ai][0][m][0] * rs + b0, v1 = acc[ai][0][m][1] * rs + b1; f32x4 o0, o1;
#pragma unroll
                        for (int c = 0; c < 4; ++c) { float x = v0[c] * 1.4426950408889634f; o0[c] = fminf(x, 0.f) - __builtin_amdgcn_logf(1.f + __builtin_amdgcn_exp2f(-fabsf(x))); x = v1[c] * 1.4426950408889634f; o1[c] = fminf(x, 0.f) - __builtin_amdgcn_logf(1.f + __builtin_amdgcn_exp2f(-fabsf(x))); }
                        *(f32x4*)(lf + (size_t)row * 8) = o0; *(f32x4*)(lf + (size_t)row * 8 + 4) = o1; asm volatile("" ::: "memory"); }
            }
            return;
        }
        int colt = u.pn * BM; bf16_t* base = O; float sc = 1.f;
        if (split_cols) { const int t = colt / split_cols; base += (size_t)t * split_stride; colt -= t * split_cols; if (t == 0) sc = scale0; }
        const int col0 = colt + wc * 32 + 8 * fq;
        float rsv[2][4];
#pragma unroll
        for (int ai = 0; ai < 2; ++ai)
#pragma unroll
            for (int m = 0; m < 4; ++m) rsv[ai][m] = row_rstd(ssq, row0 + ai * HALF + m * 16 + row_off) * sc;
#pragma unroll
        for (int ai = 0; ai < 2; ++ai)
#pragma unroll
            for (int m = 0; m < 4; ++m) { const int row = row0 + ai * HALF + m * 16; const float rs = rsv[ai][m]; bf16_t* rowp = base + (size_t)row * ldc + col0;
#pragma unroll
                for (int bj = 0; bj < 2; ++bj) { const f32x4 v0 = acc[ai][bj][m][0] * rs, v1 = acc[ai][bj][m][1] * rs;
                    u32x4 w; w.x = cvt_pk_bf16(v0[0], v0[1]); w.y = cvt_pk_bf16(v0[2], v0[3]); w.z = cvt_pk_bf16(v1[0], v1[1]); w.w = cvt_pk_bf16(v1[2], v1[3]);
                    *(u32x4*)(rowp + bj * HALF) = w; } asm volatile("" ::: "memory"); }
    }
};
struct EpiResid {
    static constexpr bool PERM = true, AFTER_DRAIN = false;
    const float* base32; bf16_t* hb; float* ssq; int row_off; PG8_LAS float* P;
    __device__ __forceinline__ void operator()(const f32x4 (&acc)[2][2][4][2], const Unit& u, int wr, int wc, int fr, int fq) const {
        asm volatile("" : "+v"(fr), "+v"(fq));
        const int row0 = row_off + u.pm * BM + wr * 64 + fr, col0 = u.pn * BM + wc * 32 + 8 * fq;
#pragma unroll
        for (int ai = 0; ai < 2; ++ai) {
            u32x4 hv4[4][2];
            if (!base32) {
#pragma unroll
                for (int m = 0; m < 4; ++m)
#pragma unroll
                    for (int bj = 0; bj < 2; ++bj) hv4[m][bj] = *(const u32x4*)(hb + (size_t)(row0 + ai * HALF + m * 16) * 1024 + col0 + bj * HALF);
            }
#pragma unroll
            for (int m = 0; m < 4; ++m) { const int row = row0 + ai * HALF + m * 16; const size_t off = (size_t)row * 1024 + col0; float s = 0.f;
#pragma unroll
                for (int bj = 0; bj < 2; ++bj) { f32x4 b0, b1;
                    if (base32) { b0 = *(const f32x4*)(base32 + off + bj * HALF); b1 = *(const f32x4*)(base32 + off + bj * HALF + 4); }
                    else { const u32x4 hv = hv4[m][bj];
                        b0 = (f32x4){__builtin_bit_cast(float, hv.x << 16), __builtin_bit_cast(float, hv.x & 0xffff0000u), __builtin_bit_cast(float, hv.y << 16), __builtin_bit_cast(float, hv.y & 0xffff0000u)};
                        b1 = (f32x4){__builtin_bit_cast(float, hv.z << 16), __builtin_bit_cast(float, hv.z & 0xffff0000u), __builtin_bit_cast(float, hv.w << 16), __builtin_bit_cast(float, hv.w & 0xffff0000u)}; }
                    const f32x4 o0 = b0 + acc[ai][bj][m][0], o1 = b1 + acc[ai][bj][m][1];
                    s += ((o0[0] * o0[0] + o0[1] * o0[1]) + (o0[2] * o0[2] + o0[3] * o0[3])) + ((o1[0] * o1[0] + o1[1] * o1[1]) + (o1[2] * o1[2] + o1[3] * o1[3]));
                    u32x4 w; w.x = cvt_pk_bf16(o0[0], o0[1]); w.y = cvt_pk_bf16(o0[2], o0[3]); w.z = cvt_pk_bf16(o1[0], o1[1]); w.w = cvt_pk_bf16(o1[2], o1[3]); *(u32x4*)(hb + off + bj * HALF) = w; }
                s += __shfl_xor(s, 16); s += __shfl_xor(s, 32);
                if (fq == 0) P[(wr * 64 + ai * HALF + m * 16 + fr) * 4 + wc] = s;
                asm volatile("" ::: "memory"); }
        }
        asm volatile("s_waitcnt lgkmcnt(0)" ::: "memory"); __builtin_amdgcn_s_barrier(); asm volatile("" ::: "memory");
        { const int t = (wr * 4 + wc) * 64 + fq * 16 + fr; if (t < 256) { const f32x4 v = *(const PG8_LAS f32x4*)(P + t * 4); ssq[(size_t)(row_off + u.pm * BM + t) * 4 + u.pn] = (v[0] + v[1]) + (v[2] + v[3]); } }
    }
};
__device__ __forceinline__ float dpp_shr1(float v) { return __builtin_bit_cast(float, __builtin_amdgcn_update_dpp(0, __builtin_bit_cast(int, v), 0x111, 0xf, 0xf, true)); }
__device__ __forceinline__ float dpp_shr2(float v) { return __builtin_bit_cast(float, __builtin_amdgcn_update_dpp(0, __builtin_bit_cast(int, v), 0x112, 0xf, 0xf, true)); }
__device__ __forceinline__ float dpp_ror1(float v) { return __builtin_bit_cast(float, __builtin_amdgcn_update_dpp(0, __builtin_bit_cast(int, v), 0x121, 0xf, 0xf, false)); }
__device__ __forceinline__ float dpp_shl15(float v) { return __builtin_bit_cast(float, __builtin_amdgcn_update_dpp(0, __builtin_bit_cast(int, v), 0x10F, 0xf, 0xf, true)); }
__device__ __forceinline__ float dpp_shl14(float v) { return __builtin_bit_cast(float, __builtin_amdgcn_update_dpp(0, __builtin_bit_cast(int, v), 0x10E, 0xf, 0xf, true)); }
__device__ __forceinline__ float dpp_ror2(float v) { return __builtin_bit_cast(float, __builtin_amdgcn_update_dpp(0, __builtin_bit_cast(int, v), 0x122, 0xf, 0xf, false)); }
struct EpiFfnAct {
    static constexpr bool PERM = true, AFTER_DRAIN = false;
    bf16_t* act; const float* ssq; const float* cw; const float* cb; float* UH; float* AP; float* GP; PG8_LAS float* X;
    __device__ __forceinline__ void operator()(const f32x4 (&acc)[2][2][4][2], const Unit& u, int wr, int wc, int fr, int fq) const {
        asm volatile("" : "+v"(fr), "+v"(fq));
        constexpr int FF = 2816;
        const int wid = wr * 4 + wc, cl = 32 * wc + 8 * fq, col = u.pn * 128 + cl, row0 = u.pm * BM + wr * 64 + fr;
        const float rs3[2] = {row_rstd(ssq, row0 + 48), row_rstd(ssq, row0 + HALF + 48)};
#pragma unroll
        for (int ai = 0; ai < 2; ++ai) { const float rs = rs3[ai];
            if (fr >= 14) { const f32x4 a = acc[ai][0][3][0] * rs, b = acc[ai][0][3][1] * rs; PG8_LAS f32x4* xp = (PG8_LAS f32x4*)(X + ((wid * 2 + ai) * 2 + (fr - 14)) * 32 + fq * 8); xp[0] = a; xp[1] = b;
                if (wr == 1 && ai == 1) { float* g = UH + ((size_t)u.pm * 2 + (fr - 14)) * FF + col; *(f32x4*)g = a; *(f32x4*)(g + 4) = b; } } }
        asm volatile("s_waitcnt lgkmcnt(0)" ::: "memory"); __builtin_amdgcn_s_barrier(); asm volatile("" ::: "memory");
        const f32x4 w0a = *(const f32x4*)(cw + col), w0b = *(const f32x4*)(cw + col + 4), w1a = *(const f32x4*)(cw + FF + col), w1b = *(const f32x4*)(cw + FF + col + 4);
        const f32x4 w2a = *(const f32x4*)(cw + 2 * FF + col), w2b = *(const f32x4*)(cw + 2 * FF + col + 4), ba = *(const f32x4*)(cb + col), bb = *(const f32x4*)(cb + col + 4);
        const float m0 = (fr == 0) ? 1.f : 0.f, m1 = (fr == 1) ? 1.f : 0.f;
#pragma unroll
        for (int ai = 0; ai < 2; ++ai) {
            f32x4 pa = {0.f, 0.f, 0.f, 0.f}, pb = {0.f, 0.f, 0.f, 0.f};
            float rsv[4];
#pragma unroll
            for (int m = 0; m < 4; ++m) rsv[m] = row_rstd(ssq, row0 + ai * HALF + m * 16);
#pragma unroll
            for (int m = 0; m < 4; ++m) {
                const int row = row0 + ai * HALF + m * 16; const float rs = rsv[m];
                const f32x4 ca = acc[ai][0][m][0] * rs, cb_ = acc[ai][0][m][1] * rs;
                f32x4 aa = w2a * ca + ba, ab = w2b * cb_ + bb;
#pragma unroll
                for (int c = 0; c < 4; ++c) { aa[c] = __builtin_fmaf(w1a[c], dpp_shr1(ca[c]), aa[c]); ab[c] = __builtin_fmaf(w1b[c], dpp_shr1(cb_[c]), ab[c]);
                    aa[c] = __builtin_fmaf(w0a[c], dpp_shr2(ca[c]), aa[c]); ab[c] = __builtin_fmaf(w0b[c], dpp_shr2(cb_[c]), ab[c]); }
                if (m == 0) {
                    if (ai == 1 || wr == 1) { const int sw = ((ai == 1 && wr == 0) ? 4 : 0) + wc, sai = (ai == 1 && wr == 1) ? 1 : 0;
                        const PG8_LAS f32x4* xp = (const PG8_LAS f32x4*)(X + ((sw * 2 + sai) * 2) * 32 + fq * 8); const f32x4 h0a = xp[0], h0b = xp[1], h1a = xp[8], h1b = xp[9];
                        aa += w1a * (h1a * m0) + w0a * (h0a * m0 + h1a * m1); ab += w1b * (h1b * m0) + w0b * (h0b * m0 + h1b * m1); }
                } else {
#pragma unroll
                    for (int c = 0; c < 4; ++c) { aa[c] = __builtin_fmaf(w1a[c], dpp_shl15(pa[c]), aa[c]); ab[c] = __builtin_fmaf(w1b[c], dpp_shl15(pb[c]), ab[c]);
                        aa[c] = __builtin_fmaf(w0a[c], dpp_shl14(pa[c]), aa[c]); ab[c] = __builtin_fmaf(w0b[c], dpp_shl14(pb[c]), ab[c]); }
                }
                const f32x4 ga = acc[ai][1][m][0] * rs, gb = acc[ai][1][m][1] * rs;
                f32x4 ea = aa * -1.4426950408889634f, eb = ab * -1.4426950408889634f;
#pragma unroll
                for (int c = 0; c < 4; ++c) { ea[c] = __builtin_amdgcn_exp2f(ea[c]); eb[c] = __builtin_amdgcn_exp2f(eb[c]); }
                ea = ea + 1.0f; eb = eb + 1.0f;
#pragma unroll
                for (int c = 0; c < 4; ++c) { ea[c] = __builtin_amdgcn_rcpf(ea[c]); eb[c] = __builtin_amdgcn_rcpf(eb[c]); }
                const f32x4 oa = (aa * ga) * ea, ob = (ab * gb) * eb;
                u32x4 w; w.x = cvt_pk_bf16(oa[0], oa[1]); w.y = cvt_pk_bf16(oa[2], oa[3]); w.z = cvt_pk_bf16(ob[0], ob[1]); w.w = cvt_pk_bf16(ob[2], ob[3]);
                *(u32x4*)(act + (size_t)row * FF + col) = w;
                if (m == 0 && ai == 0 && wr == 0 && fr < 2 && (u.pm & 15) != 0) { float* g = AP + ((size_t)u.pm * 2 + fr) * FF + col; *(f32x4*)g = aa; *(f32x4*)(g + 4) = ab;
                    float* g2 = GP + ((size_t)u.pm * 2 + fr) * FF + col; *(f32x4*)g2 = ga; *(f32x4*)(g2 + 4) = gb; }
                pa = ca; pb = cb_;
                asm volatile("" ::: "memory");
            }
        }
    }
};
template <class Epi, class Sched, bool ALIGN_EPI = false, bool SP2 = false>
__device__ __forceinline__ void gemm_phase(PG8_LAS unsigned char* lds, const Gemm g, const Sched& S, const Epi& E) {
    int tid_ = threadIdx.x; asm volatile("" : "+v"(tid_));
    const int tid = tid_, wid = __builtin_amdgcn_readfirstlane(tid >> 6), lane = tid & 63, wr = wid >> 2, wc = wid & 3, fr = lane & 15, fq = lane >> 4;
    const int K = g.K, nt = K / BK;
    unsigned voffA[2], voffB[2];
#pragma unroll
    for (int i = 0; i < 2; ++i) { int R, C; stage_rc(tid * 16 + i * 8192, R, C); const int Rb = Epi::PERM ? ((R & ~31) + perm32(R & 31)) : R;
        voffA[i] = (unsigned)(R * K + C) * 2u; voffB[i] = (unsigned)(Rb * K + C) * 2u; }
    const size_t kstep = (size_t)(BK * 2);
    const size_t hstep = (size_t)HALF * K * 2;
    const size_t tstep = 2 * hstep;
    const unsigned ldsw = (unsigned)wid * 1024u;
    const int aoff = lds_byte(wr * 64 + fr, fq * 8), boff = lds_byte(wc * 32 + fr, fq * 8);
#define PG8_SA(b, h) (((b) * 2 + (h)) * HTB)
#define PG8_SB(b, h) ((4 + (b) * 2 + (h)) * HTB)
#define PG8_STAGE(bufoff, gbase, voff) do { _Pragma("unroll") for (int _i = 0; _i < 2; ++_i) \
        __builtin_amdgcn_global_load_lds((const unsigned*)((const char*)(gbase) + (voff)[_i]), (PG8_LAS unsigned*)(lds + (bufoff) + ldsw + _i * 8192), 16, 0, 0); } while (0)
#define PG8_LDA(dst, b, h) do { _Pragma("unroll") for (int m = 0; m < 4; ++m) _Pragma("unroll") for (int k = 0; k < 2; ++k) dst[m][k] = *(const PG8_LAS bf16x8*)(lds + PG8_SA(b, h) + aoff + m * 2048 + k * 1024); } while (0)
#define PG8_LDB(dst, b, h) do { _Pragma("unroll") for (int n = 0; n < 2; ++n) _Pragma("unroll") for (int k = 0; k < 2; ++k) dst[n][k] = *(const PG8_LAS bf16x8*)(lds + PG8_SB(b, h) + boff + n * 2048 + k * 1024); } while (0)
#define PG8_MMA(ai, bj, At, Bt) do { __builtin_amdgcn_s_setprio(1); _Pragma("unroll") for (int m = 0; m < 4; ++m) _Pragma("unroll") for (int n = 0; n < 2; ++n) _Pragma("unroll") for (int k = 0; k < 2; ++k) \
        acc[ai][bj][m][n] = __builtin_amdgcn_mfma_f32_16x16x32_bf16(Bt[n][k], At[m][k], acc[ai][bj][m][n], 0, 0, 0); __builtin_amdgcn_s_setprio(0); } while (0)
#define PG8_WAIT_V(n) asm volatile("s_waitcnt vmcnt(" #n ")" ::: "memory")
#define PG8_WAIT_L(n) asm volatile("s_waitcnt lgkmcnt(" #n ")" ::: "memory")
#define PG8_BAR __builtin_amdgcn_s_barrier()
#define PG8_SCHED __builtin_amdgcn_sched_barrier(0)
    Unit cur, nxt; int ui = 0;
    if (!S.next(0, cur)) return;
    f32x4 acc[2][2][4][2];
#pragma unroll
    for (int a = 0; a < 2; ++a)
#pragma unroll
        for (int b = 0; b < 2; ++b)
#pragma unroll
            for (int m = 0; m < 4; ++m)
#pragma unroll
                for (int n = 0; n < 2; ++n) acc[a][b][m][n] = (f32x4){0.f, 0.f, 0.f, 0.f};
    bf16x8 At[4][2], B0[2][2], B1[2][2];
    const char* cA = (const char*)g.A + (size_t)cur.pm * tstep; const char* cB = (const char*)g.Bt + (size_t)cur.pn * tstep;
    S.a_ready(cur);
    if constexpr (SP2) {
        PG8_STAGE(PG8_SB(0, 0), cB, voffB); PG8_STAGE(PG8_SB(0, 1), cB + hstep, voffB); PG8_STAGE(PG8_SA(0, 0), cA, voffA); PG8_STAGE(PG8_SA(0, 1), cA + hstep, voffA);
        if (wr == 1) PG8_BAR;
        PG8_WAIT_V(2); PG8_BAR;
        PG8_STAGE(PG8_SB(1, 0), cB + kstep, voffB); PG8_STAGE(PG8_SA(1, 0), cA + kstep, voffA); PG8_STAGE(PG8_SB(1, 1), cB + hstep + kstep, voffB);
        PG8_WAIT_V(6); PG8_BAR;
    } else {
        PG8_STAGE(PG8_SB(0, 0), cB, voffB); PG8_STAGE(PG8_SA(0, 0), cA, voffA); PG8_STAGE(PG8_SB(0, 1), cB + hstep, voffB); PG8_STAGE(PG8_SA(0, 1), cA + hstep, voffA);
        if (wr == 1) PG8_BAR;
        PG8_WAIT_V(4); PG8_BAR;
        PG8_STAGE(PG8_SB(1, 0), cB + kstep, voffB); PG8_STAGE(PG8_SA(1, 0), cA + kstep, voffA); PG8_STAGE(PG8_SB(1, 1), cB + hstep + kstep, voffB);
        PG8_WAIT_V(6); PG8_BAR;
    }
    for (;;) {
        const bool has_next = S.next(ui + 1, nxt);
        const char* nA = has_next ? (const char*)g.A + (size_t)nxt.pm * tstep : cA; const char* nB = has_next ? (const char*)g.Bt + (size_t)nxt.pn * tstep : cB;
        for (int t = 0; t < nt; t += 2) {
            const bool last = (t == nt - 2);
            const char* a1 = cA + (size_t)(t + 1) * kstep;
            const char* a2 = last ? nA : cA + (size_t)(t + 2) * kstep; const char* b2 = last ? nB : cB + (size_t)(t + 2) * kstep;
            const char* a3 = a2 + kstep; const char* b3 = b2 + kstep;
            if (last && has_next) S.a_ready(nxt);
            if constexpr (SP2) {
            PG8_LDB(B0, 0, 0); PG8_LDB(B1, 0, 1); PG8_SCHED; PG8_LDA(At, 0, 0); PG8_STAGE(PG8_SA(1, 1), a1 + hstep, voffA);
            PG8_WAIT_V(8); PG8_WAIT_L(0); PG8_BAR; PG8_MMA(0, 0, At, B0); PG8_MMA(0, 1, At, B1); PG8_BAR; PG8_SCHED;
            PG8_LDA(At, 0, 1); PG8_STAGE(PG8_SB(0, 0), b2, voffB); PG8_STAGE(PG8_SB(0, 1), b2 + hstep, voffB); PG8_STAGE(PG8_SA(0, 0), a2, voffA);
            PG8_WAIT_V(8); PG8_WAIT_L(0); PG8_BAR; PG8_MMA(1, 0, At, B0); PG8_MMA(1, 1, At, B1); PG8_BAR; PG8_SCHED;
            PG8_LDB(B0, 1, 0); PG8_LDB(B1, 1, 1); PG8_SCHED; PG8_LDA(At, 1, 0); PG8_STAGE(PG8_SA(0, 1), a2 + hstep, voffA);
            PG8_WAIT_V(8); PG8_WAIT_L(0); PG8_BAR; PG8_MMA(0, 0, At, B0); PG8_MMA(0, 1, At, B1); PG8_BAR; PG8_SCHED;
            PG8_LDA(At, 1, 1); PG8_STAGE(PG8_SB(1, 0), b3, voffB); PG8_STAGE(PG8_SB(1, 1), b3 + hstep, voffB); PG8_STAGE(PG8_SA(1, 0), a3, voffA);
            PG8_WAIT_V(8); PG8_WAIT_L(0); PG8_BAR; PG8_MMA(1, 0, At, B0); PG8_MMA(1, 1, At, B1); PG8_BAR; PG8_SCHED;
            } else {
            PG8_LDB(B0, 0, 0); PG8_SCHED; PG8_LDA(At, 0, 0); PG8_STAGE(PG8_SA(1, 1), a1 + hstep, voffA);
            PG8_WAIT_L(8); PG8_BAR; PG8_WAIT_L(0); PG8_MMA(0, 0, At, B0); PG8_BAR; PG8_SCHED;
            PG8_LDB(B1, 0, 1); PG8_STAGE(PG8_SB(0, 0), b2, voffB);
            PG8_BAR; PG8_WAIT_L(0); PG8_MMA(0, 1, At, B1); PG8_BAR;
            PG8_LDA(At, 0, 1); PG8_STAGE(PG8_SA(0, 0), a2, voffA);
            PG8_BAR; PG8_WAIT_L(0); PG8_MMA(1, 0, At, B0); PG8_BAR; PG8_SCHED;
            PG8_STAGE(PG8_SB(0, 1), b2 + hstep, voffB);
            PG8_WAIT_V(6); PG8_BAR; PG8_MMA(1, 1, At, B1); PG8_BAR;
            PG8_LDB(B0, 1, 0); PG8_SCHED; PG8_LDA(At, 1, 0); PG8_STAGE(PG8_SA(0, 1), a2 + hstep, voffA);
            PG8_WAIT_L(8); PG8_BAR; PG8_WAIT_L(0); PG8_MMA(0, 0, At, B0); PG8_BAR; PG8_SCHED;
            PG8_LDB(B1, 1, 1); PG8_STAGE(PG8_SB(1, 0), b3, voffB);
            PG8_BAR; PG8_WAIT_L(0); PG8_MMA(0, 1, At, B1); PG8_BAR;
            PG8_LDA(At, 1, 1); PG8_STAGE(PG8_SA(1, 0), a3, voffA);
            PG8_BAR; PG8_WAIT_L(0); PG8_MMA(1, 0, At, B0); PG8_BAR; PG8_SCHED;
            PG8_STAGE(PG8_SB(1, 1), b3 + hstep, voffB);
            PG8_WAIT_V(6); PG8_BAR; PG8_MMA(1, 1, At, B1); PG8_BAR;
            }
        }
        if constexpr (ALIGN_EPI) { if (wr == 0) PG8_BAR; }
        if constexpr (!Epi::AFTER_DRAIN) { E(acc, cur, wr, wc, fr, fq); S.done(cur); }
        if (!has_next) break;
#pragma unroll
        for (int a = 0; a < 2; ++a)
#pragma unroll
            for (int b = 0; b < 2; ++b)
#pragma unroll
                for (int m = 0; m < 4; ++m)
#pragma unroll
                    for (int n = 0; n < 2; ++n) acc[a][b][m][n] = (f32x4){0.f, 0.f, 0.f, 0.f};
        cur = nxt; cA = nA; cB = nB; ++ui;
        if constexpr (ALIGN_EPI) { if (wr == 1) PG8_BAR; }
    }
    PG8_WAIT_V(0);
    if constexpr (!ALIGN_EPI) { if (wr == 0) PG8_BAR; }
    PG8_BAR;
    if constexpr (Epi::AFTER_DRAIN) { E.fused(acc, cur, wr, wc, fr, fq, lds, wid, lane); S.done(cur); }
#undef PG8_SA
#undef PG8_SB
#undef PG8_STAGE
#undef PG8_LDA
#undef PG8_LDB
#undef PG8_MMA
#undef PG8_WAIT_V
#undef PG8_WAIT_L
#undef PG8_BAR
#undef PG8_SCHED
}
}

typedef unsigned short bf16_t;
typedef short bf16x8 __attribute__((ext_vector_type(8)));
typedef float f32x4 __attribute__((ext_vector_type(4)));
typedef unsigned u32x4 __attribute__((ext_vector_type(4)));
typedef unsigned u32x2 __attribute__((ext_vector_type(2)));
#define LAS __attribute__((address_space(3)))
constexpr int MROWS = 32768, DM = 1024, SEQ = 4096, NB = 8, DFF = 2816;
constexpr int EV_N = 2048, OD_N = 3080, OD_NP = 3328, FF_N = 5632;
constexpr float LOG2E = 1.4426950408889634f;
constexpr int NTHREADS = 512, NWAVES = 8;
constexpr int LDS_BYTES = 163840;
constexpr size_t MiB = 1u << 20;
constexpr size_t WS_EVIN = 0, WS_EVOUT = 8 * MiB, WS_ODIN = 12 * MiB, WS_ODOUT = 25 * MiB, WS_FFIN = 29 * MiB, WS_FFOUT = 73 * MiB, WS_POOL = 95 * MiB;
constexpr size_t WS_KNT = 100 * MiB + 768 * 1024;
constexpr size_t WS_SSQ = 96 * MiB, WS_LF = 98 * MiB, WS_F2 = 99 * MiB, WS_KMEAN = 100 * MiB, WS_HB = 101 * MiB, WS_R2 = 165 * MiB, WS_R1 = 253 * MiB, WS_END = 445 * MiB;
constexpr int FF_HALVES = 2, MH = MROWS / FF_HALVES;

struct Params { const float* in[17]; float* out; unsigned char* ws; int ph_lo, ph_hi; };
enum { I_X = 0, I_MIXG, I_FFNG, I_FING, I_EVWIN, I_EVCONV, I_EVPOOLW, I_EVPOOLS, I_EVWOUT, I_ODWIN, I_ODBF, I_ODWOUT, I_RELB, I_FFWIN, I_FFCONVW, I_FFCONVB, I_FFWOUT };

__device__ __forceinline__ unsigned f2bf(float f) { unsigned u = __builtin_bit_cast(unsigned, f); return (u + 0x7fffu + ((u >> 16) & 1u)) >> 16; }
typedef float f32x2_t __attribute__((ext_vector_type(2))); typedef __bf16 bf16x2_t __attribute__((ext_vector_type(2)));
__device__ __forceinline__ unsigned pk2(float lo, float hi) { const f32x2_t v = {lo, hi}; const bf16x2_t b = __builtin_convertvector(v, bf16x2_t); return __builtin_bit_cast(unsigned, b); }
__device__ __forceinline__ float bf_lo(unsigned u) { return __builtin_bit_cast(float, u << 16); }
__device__ __forceinline__ float bf_hi(unsigned u) { return __builtin_bit_cast(float, u & 0xffff0000u); }
__device__ __forceinline__ float wave_sum(float v) {
#pragma unroll
    for (int o = 1; o < 64; o <<= 1) v += __shfl_xor(v, o);
    return v;
}

__device__ __forceinline__ void transpose_item(const float* W, int K, int N, int NP, bf16_t* WT, const float* gvec, int mode, float* scr, int item, int lane) {
    const int nblk = NP / 64, kb = item / nblk, nb = item % nblk, k0 = 64 * kb, n0 = 64 * nb;
    const int nq = 4 * (lane & 15), n = n0 + nq;
#pragma unroll 8
    for (int i = 0; i < 16; ++i) { const int kk = 4 * i + (lane >> 4);
        f32x4 v = {0.f, 0.f, 0.f, 0.f}; if (n < N) v = *(const f32x4*)(W + (size_t)(k0 + kk) * N + n); if (gvec) v = v * gvec[k0 + kk];
        float* d = scr + kk * 65 + nq; d[0] = v[0]; d[1] = v[1]; d[2] = v[2]; d[3] = v[3]; }
    asm volatile("s_waitcnt lgkmcnt(0)" ::: "memory");
    const int c = lane & 7;
#pragma unroll
    for (int j = 0; j < 8; ++j) { const int nl = (lane >> 3) + 8 * j; const float* sp = scr + (8 * c) * 65 + nl; int nn = n0 + nl;
        if (mode == 1) { nn = (nn < DFF) ? ((nn >> 7) * 256 + (nn & 127)) : ((((nn - DFF) >> 7) * 256) + 128 + ((nn - DFF) & 127)); }
        u32x4 o; o.x = pk2(sp[0 * 65], sp[1 * 65]); o.y = pk2(sp[2 * 65], sp[3 * 65]); o.z = pk2(sp[4 * 65], sp[5 * 65]); o.w = pk2(sp[6 * 65], sp[7 * 65]);
        *(u32x4*)(WT + (size_t)nn * K + k0 + 8 * c) = o; }
    asm volatile("s_waitcnt lgkmcnt(0)" ::: "memory");
}
__device__ __forceinline__ void phase_prologue(const Params& p, unsigned char* lds) {
    int tid_ = threadIdx.x; asm volatile("" : "+v"(tid_)); const int tid = tid_, lane = tid & 63, wave = tid >> 6;
    float* scr = (float*)(lds + wave * 16896);
    const int gw = blockIdx.x * NWAVES + wave, NGW = gridDim.x * NWAVES;
    unsigned char* ws = p.ws;
    constexpr int I_EI = 16 * (EV_N / 64), I_EO = 16 * 16, I_OI = 16 * (OD_NP / 64), I_OO = 16 * 16, I_FI = 16 * (FF_N / 64), I_FO = (DFF / 64) * 16, I_PW = 2 * 2;
    constexpr int NITEMS = 2 * I_EI + 2 * I_EO + 2 * I_OI + 2 * I_OO + 4 * I_FI + 4 * I_FO + 8 * I_PW;
    for (int it = gw; it < NITEMS; it += NGW) {
        int r = it;
        if (r < 2 * I_EI) { const int e = r / I_EI; transpose_item(p.in[I_EVWIN] + (size_t)e * DM * EV_N, DM, EV_N, EV_N, (bf16_t*)(ws + WS_EVIN) + (size_t)e * EV_N * DM, p.in[I_MIXG] + (2 * e) * DM, 0, scr, r % I_EI, lane); continue; } r -= 2 * I_EI;
        if (r < 2 * I_EO) { const int e = r / I_EO; transpose_item(p.in[I_EVWOUT] + (size_t)e * DM * DM, DM, DM, DM, (bf16_t*)(ws + WS_EVOUT) + (size_t)e * DM * DM, nullptr, 0, scr, r % I_EO, lane); continue; } r -= 2 * I_EO;
        if (r < 2 * I_OI) { const int e = r / I_OI; transpose_item(p.in[I_ODWIN] + (size_t)e * DM * OD_N, DM, OD_N, OD_NP, (bf16_t*)(ws + WS_ODIN) + (size_t)e * OD_NP * DM, p.in[I_MIXG] + (2 * e + 1) * DM, 0, scr, r % I_OI, lane); continue; } r -= 2 * I_OI;
        if (r < 2 * I_OO) { const int e = r / I_OO; transpose_item(p.in[I_ODWOUT] + (size_t)e * DM * DM, DM, DM, DM, (bf16_t*)(ws + WS_ODOUT) + (size_t)e * DM * DM, nullptr, 0, scr, r % I_OO, lane); continue; } r -= 2 * I_OO;
        if (r < 4 * I_FI) { const int e = r / I_FI; transpose_item(p.in[I_FFWIN] + (size_t)e * DM * FF_N, DM, FF_N, FF_N, (bf16_t*)(ws + WS_FFIN) + (size_t)e * FF_N * DM, p.in[I_FFNG] + e * DM, 1, scr, r % I_FI, lane); continue; } r -= 4 * I_FI;
        if (r < 4 * I_FO) { const int e = r / I_FO; transpose_item(p.in[I_FFWOUT] + (size_t)e * DFF * DM, DFF, DM, DM, (bf16_t*)(ws + WS_FFOUT) + (size_t)e * DM * DFF, nullptr, 0, scr, r % I_FO, lane); continue; } r -= 4 * I_FO;
        { const int e = r / I_PW; transpose_item(p.in[I_EVPOOLW] + (size_t)e * 128 * 128, 128, 128, 128, (bf16_t*)(ws + WS_POOL) + (size_t)e * 128 * 128, nullptr, 0, scr, r % I_PW, lane); }
    }
    const float* x = p.in[I_X]; bf16_t* hb = (bf16_t*)(ws + WS_HB); float* ssq = (float*)(ws + WS_SSQ);
    { f32x4 nv[4];
      if (gw < MROWS) { const f32x4* xr = (const f32x4*)(x + (size_t)gw * DM) + lane;
#pragma unroll
          for (int j = 0; j < 4; ++j) nv[j] = xr[64 * j]; }
      for (int m = gw; m < MROWS; m += NGW) {
        f32x4 v[4]; float s = 0.f;
#pragma unroll
        for (int j = 0; j < 4; ++j) v[j] = nv[j];
        if (m + NGW < MROWS) { const f32x4* xr = (const f32x4*)(x + (size_t)(m + NGW) * DM) + lane;
#pragma unroll
            for (int j = 0; j < 4; ++j) nv[j] = xr[64 * j]; }
#pragma unroll
        for (int j = 0; j < 4; ++j) s += (v[j][0] * v[j][0] + v[j][1] * v[j][1]) + (v[j][2] * v[j][2] + v[j][3] * v[j][3]);
        s = wave_sum(s);
        u32x2* o8 = (u32x2*)(hb + (size_t)m * DM) + lane;
#pragma unroll
        for (int j = 0; j < 4; ++j) { u32x2 w; w.x = pk2(v[j][0], v[j][1]); w.y = pk2(v[j][2], v[j][3]); o8[64 * j] = w; }
        if (lane < 4) ssq[(size_t)m * 4 + lane] = (lane == 0) ? s : 0.f;
      } }
}

__device__ __forceinline__ void phase_evmix(const Params& p, unsigned char* lds, int e) {
    int tid_ = threadIdx.x; asm volatile("" : "+v"(tid_)); const int tid = tid_, lane = tid & 63, wave = tid >> 6, fr = lane & 15, fq = lane >> 4;
    const bf16_t* z = (const bf16_t*)(p.ws + WS_R1); bf16_t* y = (bf16_t*)(p.ws + WS_R2);
    const float* cw = p.in[I_EVCONV] + (size_t)e * 3 * 512; const float* pscale = p.in[I_EVPOOLS] + (size_t)e * 512;
    const bf16_t* poolT = (const bf16_t*)(p.ws + WS_POOL) + (size_t)e * 4 * 128 * 128;
    float* CV = (float*)lds;
    bf16_t* Zp = (bf16_t*)lds;
    bf16_t* Pl = (bf16_t*)(lds + 40960);
    bf16_t* Bl = (bf16_t*)(lds + 77824);
    u32x4 pa[5], pb[5], pg[4];
    const int NU = 256 * 8, G = gridDim.x;
#define EV_LOAD(uu) do { const int part_ = (uu) & 7, t0_ = ((uu) >> 3) * 128, pos0_ = t0_ & (SEQ - 1); \
        if (part_ < 4) { const int cb_ = part_ * 128; \
            _Pragma("unroll") for (int k = 0; k < 5; ++k) { const int it_ = tid + k * NTHREADS; const int r_ = it_ >> 4, ch_ = it_ & 15; pa[k] = (u32x4){0u, 0u, 0u, 0u}; pb[k] = pa[k]; \
                if (it_ < 130 * 16 && pos0_ + r_ - 2 >= 0) { pa[k] = *(const u32x4*)(z + (size_t)(t0_ + r_ - 2) * EV_N + 512 + cb_ + ch_ * 8); pb[k] = *(const u32x4*)(z + (size_t)(t0_ + r_ - 2) * EV_N + 1024 + cb_ + ch_ * 8); } } \
            _Pragma("unroll") for (int k = 0; k < 4; ++k) { const int it_ = tid + k * NTHREADS; pg[k] = *(const u32x4*)(z + (size_t)(t0_ + (it_ >> 4)) * EV_N + cb_ + (it_ & 15) * 8); } \
        } else { const int cb_ = 1536 + (part_ - 4) * 128; \
            _Pragma("unroll") for (int k = 0; k < 5; ++k) { const int it_ = tid + k * NTHREADS; const int r_ = it_ >> 4, ch_ = it_ & 15; pa[k] = (u32x4){0u, 0u, 0u, 0u}; \
                if (it_ < 143 * 16 && pos0_ + r_ - 15 >= 0) pa[k] = *(const u32x4*)(z + (size_t)(t0_ + r_ - 15) * EV_N + cb_ + ch_ * 8); } } } while (0)
    int gl = -1;
    int u = ((gridDim.x & 7) == 0) ? (int)((blockIdx.x & 7) * (gridDim.x >> 3) + (blockIdx.x >> 3)) : (int)blockIdx.x;
    if (u < NU) EV_LOAD(u);
    for (; u < NU; u += G) {
        const int part = u & 7, rt = u >> 3; const int t0 = rt * 128; const int pos0 = t0 & (SEQ - 1);
        __syncthreads();
        if (part < 4) {
            const int cbase = part * 128, c0 = cbase + (tid & 15) * 8;
            const f32x4 w0a = *(const f32x4*)(cw + c0), w0b = *(const f32x4*)(cw + c0 + 4), w1a = *(const f32x4*)(cw + 512 + c0), w1b = *(const f32x4*)(cw + 512 + c0 + 4), w2a = *(const f32x4*)(cw + 1024 + c0), w2b = *(const f32x4*)(cw + 1024 + c0 + 4);
#pragma unroll
            for (int k = 0; k < 5; ++k) { const int it = tid + k * NTHREADS; if (it < 130 * 16) { const int r = it >> 4, ch = it & 15; const u32x4 gc = pa[k], vv = pb[k];
                const f32x4 a = {bf_lo(gc[0]) * bf_lo(vv[0]), bf_hi(gc[0]) * bf_hi(vv[0]), bf_lo(gc[1]) * bf_lo(vv[1]), bf_hi(gc[1]) * bf_hi(vv[1])};
                const f32x4 b = {bf_lo(gc[2]) * bf_lo(vv[2]), bf_hi(gc[2]) * bf_hi(vv[2]), bf_lo(gc[3]) * bf_lo(vv[3]), bf_hi(gc[3]) * bf_hi(vv[3])};
                *(f32x4*)(CV + r * 128 + ch * 8) = a; *(f32x4*)(CV + r * 128 + ch * 8 + 4) = b; } }
            u32x4 gb[4];
#pragma unroll
            for (int k = 0; k < 4; ++k) gb[k] = pg[k];
            if (u + G < NU) EV_LOAD(u + G);
            __syncthreads();
#pragma unroll
            for (int k = 0; k < 4; ++k) { const int it = tid + k * NTHREADS; const int r = it >> 4;
                const float* cp = CV + r * 128 + (tid & 15) * 8;
                const f32x4 ca = w0a * *(const f32x4*)(cp) + w1a * *(const f32x4*)(cp + 128) + w2a * *(const f32x4*)(cp + 256);
                const f32x4 cb = w0b * *(const f32x4*)(cp + 4) + w1b * *(const f32x4*)(cp + 132) + w2b * *(const f32x4*)(cp + 260);
                const u32x4 g = gb[k]; u32x4 w;
                w.x = pk2(bf_lo(g[0]) * ca[0], bf_hi(g[0]) * ca[1]); w.y = pk2(bf_lo(g[1]) * ca[2], bf_hi(g[1]) * ca[3]); w.z = pk2(bf_lo(g[2]) * cb[0], bf_hi(g[2]) * cb[1]); w.w = pk2(bf_lo(g[3]) * cb[2], bf_hi(g[3]) * cb[3]);
                *(u32x4*)(y + (size_t)(t0 + r) * DM + c0) = w; }
        } else {
            const int g = part - 4, win = 2 << g;
            if (g != gl) {
                const bf16_t* Bt = poolT + (size_t)g * 128 * 128;
#pragma unroll
                for (int k = 0; k < 4; ++k) { const int it = tid + k * NTHREADS; const int n = it >> 4, ch = it & 15; *(u32x4*)(Bl + n * 136 + ch * 8) = *(const u32x4*)(Bt + (size_t)n * 128 + ch * 8); }
                gl = g; }
            f32x4 sc[8];
#pragma unroll
            for (int nb = 0; nb < 8; ++nb) sc[nb] = *(const f32x4*)(pscale + g * 128 + 16 * nb + 4 * fq);
#pragma unroll
            for (int k = 0; k < 5; ++k) { const int it = tid + k * NTHREADS; if (it < 143 * 16) *(u32x4*)(Zp + (it >> 4) * 128 + (it & 15) * 8) = pa[k]; }
            if (u + G < NU) EV_LOAD(u + G);
            __syncthreads();
#pragma unroll
            for (int k = 0; k < 4; ++k) { const int it = tid + k * NTHREADS; const int r = it >> 4, ch = it & 15; const int pos = pos0 + r;
                float sum[8];
#pragma unroll
                for (int j = 0; j < 8; ++j) sum[j] = 0.f;
                for (int i = 0; i < win; ++i) { const u32x4 v = *(const u32x4*)(Zp + (r + 15 - i) * 128 + ch * 8);
#pragma unroll
                    for (int j = 0; j < 4; ++j) { sum[2 * j] += bf_lo(v[j]); sum[2 * j + 1] += bf_hi(v[j]); } }
                const u32x4 xv = *(const u32x4*)(Zp + (r + 15) * 128 + ch * 8); const float inv = 1.0f / (float)((pos + 1 < win) ? pos + 1 : win);
                u32x4 w;
                w.x = pk2(sum[0] * inv - bf_lo(xv[0]), sum[1] * inv - bf_hi(xv[0])); w.y = pk2(sum[2] * inv - bf_lo(xv[1]), sum[3] * inv - bf_hi(xv[1]));
                w.z = pk2(sum[4] * inv - bf_lo(xv[2]), sum[5] * inv - bf_hi(xv[2])); w.w = pk2(sum[6] * inv - bf_lo(xv[3]), sum[7] * inv - bf_hi(xv[3]));
                *(u32x4*)(Pl + r * 136 + ch * 8) = w; }
            __syncthreads();
            f32x4 acc[8];
#pragma unroll
            for (int nb = 0; nb < 8; ++nb) acc[nb] = (f32x4){0.f, 0.f, 0.f, 0.f};
#pragma unroll
            for (int ks = 0; ks < 4; ++ks) { const bf16x8 a = *(const bf16x8*)(Pl + (16 * wave + fr) * 136 + 32 * ks + 8 * fq);
#pragma unroll
                for (int nb = 0; nb < 8; ++nb) { const bf16x8 b = *(const bf16x8*)(Bl + (16 * nb + fr) * 136 + 32 * ks + 8 * fq); acc[nb] = __builtin_amdgcn_mfma_f32_16x16x32_bf16(b, a, acc[nb], 0, 0, 0); } }
            const int row = rt * 128 + 16 * wave + fr;
#pragma unroll
            for (int nb = 0; nb < 8; ++nb) { const int col = g * 128 + 16 * nb + 4 * fq; const f32x4 o = acc[nb] * sc[nb];
                u32x2 w; w.x = pk2(o[0], o[1]); w.y = pk2(o[2], o[3]); *(u32x2*)(y + (size_t)row * DM + 512 + col) = w; }
        }
    }
#undef EV_LOAD
    __syncthreads();
}

__device__ __forceinline__ void phase_ffnact(const Params& p, int layer, const bf16_t* ug, bf16_t* act, int rows) {
    const float* cw = p.in[I_FFCONVW] + (size_t)layer * 3 * DFF; const float* cb = p.in[I_FFCONVB] + (size_t)layer * DFF;
    constexpr int NCH = DFF / 8, RUN = 16;
    const int nitems = (rows / RUN) * NCH;
    int tid_ = threadIdx.x; asm volatile("" : "+v"(tid_));
    for (int it = blockIdx.x * NTHREADS + tid_; it < nitems; it += gridDim.x * NTHREADS) {
        const int ch = it % NCH, rr = it / NCH; const int c0 = ch * 8; const int t0 = rr * RUN, pos0 = t0 & (SEQ - 1);
        const int ucol = (c0 >> 7) * 256 + (c0 & 127);
        float w0[8], w1[8], w2[8], bb[8];
#pragma unroll
        for (int j = 0; j < 8; ++j) { w0[j] = cw[c0 + j]; w1[j] = cw[DFF + c0 + j]; w2[j] = cw[2 * DFF + c0 + j]; bb[j] = cb[c0 + j]; }
        float u1[8], u2[8];
#pragma unroll
        for (int j = 0; j < 8; ++j) { u1[j] = 0.f; u2[j] = 0.f; }
        if (pos0 >= 2) { const u32x4 a = *(const u32x4*)(ug + (size_t)(t0 - 2) * FF_N + ucol), b = *(const u32x4*)(ug + (size_t)(t0 - 1) * FF_N + ucol);
#pragma unroll
            for (int j = 0; j < 4; ++j) { u2[2 * j] = bf_lo(a[j]); u2[2 * j + 1] = bf_hi(a[j]); u1[2 * j] = bf_lo(b[j]); u1[2 * j + 1] = bf_hi(b[j]); } }
#pragma unroll 4
        for (int i = 0; i < RUN; ++i) { const size_t ro = (size_t)(t0 + i) * FF_N + ucol; const u32x4 uu = *(const u32x4*)(ug + ro), gg = *(const u32x4*)(ug + ro + 128);
            float uc[8], gv[8], o[8];
#pragma unroll
            for (int j = 0; j < 4; ++j) { uc[2 * j] = bf_lo(uu[j]); uc[2 * j + 1] = bf_hi(uu[j]); gv[2 * j] = bf_lo(gg[j]); gv[2 * j + 1] = bf_hi(gg[j]); }
#pragma unroll
            for (int j = 0; j < 8; ++j) { const float a = w0[j] * u2[j] + w1[j] * u1[j] + w2[j] * uc[j] + bb[j]; o[j] = a / (1.f + __expf(-a)) * gv[j]; u2[j] = u1[j]; u1[j] = uc[j]; }
            u32x4 w; w.x = pk2(o[0], o[1]); w.y = pk2(o[2], o[3]); w.z = pk2(o[4], o[5]); w.w = pk2(o[6], o[7]);
            *(u32x4*)(act + (size_t)(t0 + i) * DFF + c0) = w; }
    }
}


__device__ __forceinline__ void ffnfix_pm(const Params& p, int layer, int pm) {
    if ((pm & 15) == 0) return;
    const float* cw = p.in[I_FFCONVW] + (size_t)layer * 3 * DFF;
    const float* UH = (const float*)(p.ws + WS_R2); const float* AP = UH + (size_t)128 * 2 * DFF; const float* GP = AP + (size_t)128 * 2 * DFF;
    bf16_t* act = (bf16_t*)(p.ws + WS_R1);
    int tid_ = threadIdx.x; asm volatile("" : "+v"(tid_));
    constexpr int NCH = DFF / 4;
    for (int it = tid_; it < NCH; it += NTHREADS) {
        const int c0 = it * 4;
        const f32x4 w0 = *(const f32x4*)(cw + c0), w1 = *(const f32x4*)(cw + DFF + c0);
        const f32x4 um2 = *(const f32x4*)(UH + ((size_t)(pm - 1) * 2 + 0) * DFF + c0), um1 = *(const f32x4*)(UH + ((size_t)(pm - 1) * 2 + 1) * DFF + c0);
        const f32x4 a0 = *(const f32x4*)(AP + ((size_t)pm * 2 + 0) * DFF + c0) + w0 * um2 + w1 * um1, a1 = *(const f32x4*)(AP + ((size_t)pm * 2 + 1) * DFF + c0) + w0 * um1;
        const f32x4 g0 = *(const f32x4*)(GP + ((size_t)pm * 2 + 0) * DFF + c0), g1 = *(const f32x4*)(GP + ((size_t)pm * 2 + 1) * DFF + c0);
        f32x4 o0, o1;
#pragma unroll
        for (int c = 0; c < 4; ++c) { o0[c] = a0[c] * __builtin_amdgcn_rcpf(1.f + __builtin_amdgcn_exp2f(a0[c] * -1.4426950408889634f)) * g0[c]; o1[c] = a1[c] * __builtin_amdgcn_rcpf(1.f + __builtin_amdgcn_exp2f(a1[c] * -1.4426950408889634f)) * g1[c]; }
        u32x2 w; w.x = pk2(o0[0], o0[1]); w.y = pk2(o0[2], o0[3]); *(u32x2*)(act + (size_t)(pm * 256) * DFF + c0) = w;
        w.x = pk2(o1[0], o1[1]); w.y = pk2(o1[2], o1[3]); *(u32x2*)(act + (size_t)(pm * 256 + 1) * DFF + c0) = w;
    }
}

__device__ __forceinline__ void phase_scan_kmean(const Params& p, unsigned char* lds) {
    int tid_ = threadIdx.x; asm volatile("" : "+v"(tid_)); const int tid = tid_, lane = tid & 63, wave = tid >> 6;
    const float* lf = (const float*)(p.ws + WS_LF); float* F2 = (float*)(p.ws + WS_F2); float* kmean = (float*)(p.ws + WS_KMEAN);
    const bf16_t* Kg = (const bf16_t*)(p.ws + WS_R1) + (size_t)MROWS * DM;
    float* red = (float*)lds; float* redn = red + 1024;
    float* knt = (float*)(p.ws + WS_KNT);
    const int NU = 64 + 2048, G = gridDim.x; const int ch = tid & 7, rg = tid >> 3;
    u32x4 nk[4];
#define KB_LOAD(uu) do { if ((uu) >= 64 && (uu) < NU) { const int k_ = (uu) - 64; const int blk_ = k_ & 15, h_ = (k_ >> 4) & 15, b_ = k_ >> 8; \
        _Pragma("unroll") for (int i = 0; i < 4; ++i) nk[i] = *(const u32x4*)(Kg + ((size_t)b_ * SEQ + blk_ * 256 + rg * 4 + i) * DM + h_ * 64 + ch * 8); } } while (0)
    int u = blockIdx.x;
    KB_LOAD(u);
    for (; u < NU; u += G) {
        __syncthreads();
        if (u < 64) {
            KB_LOAD(u + G);
            const int b = u >> 3, h = u & 7; float v[8]; float s = 0.f;
#pragma unroll
            for (int i = 0; i < 8; ++i) { s += lf[((size_t)b * SEQ + tid * 8 + i) * 8 + h]; v[i] = s; }
            float incl = s;
#pragma unroll
            for (int o = 1; o < 64; o <<= 1) { const float t = __shfl_up(incl, o); if (lane >= o) incl += t; }
            if (lane == 63) red[wave] = incl;
            __syncthreads();
            float off = incl - s;
            for (int w = 0; w < wave; ++w) off += red[w];
#pragma unroll
            for (int i = 0; i < 8; ++i) F2[((size_t)b * 8 + h) * SEQ + tid * 8 + i] = v[i] + off;
        } else {
            const int k = u - 64; const int blk = k & 15, h = (k >> 4) & 15, b = k >> 8;
            u32x4 ck[4];
#pragma unroll
            for (int i = 0; i < 4; ++i) ck[i] = nk[i];
            KB_LOAD(u + G);
            float s[8], mxn = 0.f;
#pragma unroll
            for (int j = 0; j < 8; ++j) s[j] = 0.f;
#pragma unroll
            for (int i = 0; i < 4; ++i) { float sq = 0.f;
#pragma unroll
                for (int j = 0; j < 4; ++j) { const float a = bf_lo(ck[i][j]), c = bf_hi(ck[i][j]); sq += a * a + c * c; s[2 * j] += a; s[2 * j + 1] += c; }
                sq += __shfl_xor(sq, 1); sq += __shfl_xor(sq, 2); sq += __shfl_xor(sq, 4); mxn = fmaxf(mxn, sq); }
            mxn = fmaxf(mxn, __shfl_xor(mxn, 8)); mxn = fmaxf(mxn, __shfl_xor(mxn, 16)); mxn = fmaxf(mxn, __shfl_xor(mxn, 32));
            if (lane == 0) redn[wave] = mxn;
            if (h >= 8) {
#pragma unroll
                for (int j = 0; j < 8; ++j) { float t = s[j]; t += __shfl_xor(t, 8); t += __shfl_xor(t, 16); t += __shfl_xor(t, 32); s[j] = t; }
                if (lane < 8) {
#pragma unroll
                    for (int j = 0; j < 8; ++j) red[wave * 64 + lane * 8 + j] = s[j]; }
            }
            __syncthreads();
            if (tid < 4) knt[((size_t)b * 16 + h) * 64 + blk * 4 + tid] = fmaxf(redn[2 * tid], redn[2 * tid + 1]);
            if (h >= 8 && tid < 64) { float t = 0.f;
#pragma unroll
                for (int w = 0; w < 8; ++w) t += red[w * 64 + tid];
                kmean[(((size_t)b * 8 + (h - 8)) * 16 + blk) * 64 + tid] = t * (1.0f / 256.0f); }
        }
    }
#undef KB_LOAD
    __syncthreads();
}

constexpr float NEGBIG = -1.0e30f;
template <bool MOBA>
__device__ __forceinline__ void attn_unit(unsigned char* lds, LAS unsigned char* lds3, const Params& p, int b, int h, int qb) {
    int tid_ = threadIdx.x; asm volatile("" : "+v"(tid_)); const int tid = tid_, lane = tid & 63, w = __builtin_amdgcn_readfirstlane(tid >> 6), fr = lane & 15, fq = lane >> 4;
    const bf16_t* Qg = (const bf16_t*)(p.ws + WS_R1); const bf16_t* Kg = Qg + (size_t)MROWS * DM; const bf16_t* Vg = Kg + (size_t)MROWS * DM;
    bf16_t* Og = (bf16_t*)(p.ws + WS_R2);
    const int hcol = (MOBA ? 8 + h : h) * 64; const size_t rowbase = (size_t)b * SEQ;
    LAS bf16_t* Ks = (LAS bf16_t*)lds3; LAS bf16_t* Vt = (LAS bf16_t*)(lds3 + 36864);
    LAS float* Fs = (LAS float*)(lds3 + 73728); LAS float* kms = Fs; LAS float* tbl = (LAS float*)(lds3 + 73728 + 4096); LAS unsigned* sel = (LAS unsigned*)(lds3 + 73728 + 4096 + 512);
    const int NT = 4 * (qb + 1);
    const int skey = tid >> 3, sch = tid & 7;
    const bf16_t* kp = Kg + (rowbase + skey) * DM + hcol + sch * 8; const bf16_t* vp = Vg + (rowbase + skey) * DM + hcol + sch * 8;
    u32x4 kreg[2], vreg[2];
#pragma unroll
    for (int sb = 0; sb < 2; ++sb) { kreg[sb] = *(const u32x4*)(kp + (size_t)(NT - 1 - sb) * 64 * DM); vreg[sb] = *(const u32x4*)(vp + (size_t)(NT - 1 - sb) * 64 * DM); }
    const size_t qrow0 = rowbase + qb * 256 + 32 * w;
    bf16x8 qf[2][2];
#pragma unroll
    for (int jb = 0; jb < 2; ++jb)
#pragma unroll
        for (int ks = 0; ks < 2; ++ks) qf[jb][ks] = *(const bf16x8*)(Qg + (qrow0 + 16 * jb + fr) * DM + hcol + 32 * ks + 8 * fq);
    __syncthreads();
    float c31 = 0.f, bmax = -1.0e30f;
    if (tid < 64) ((LAS float*)(lds3 + 73728 + 16384 + 2048))[64 + tid] = (tid < NT) ? ((const float*)(p.ws + WS_KNT))[((size_t)b * 16 + (MOBA ? 8 + h : h)) * 64 + tid] : 0.f;
    LAS float* kpms = (LAS float*)(lds3 + 73728 + 16384 + 2048);
    volatile LAS unsigned* dflag = (volatile LAS unsigned*)(lds3 + 73728 + 16384 + 2048 + 512);
    if (!MOBA) {
        const float* F2 = (const float*)(p.ws + WS_F2) + ((size_t)b * 8 + h) * SEQ;
        for (int i = tid; i < 256 * (qb + 1); i += NTHREADS) Fs[i] = F2[i];
        if (tid < 16) dflag[tid] = 0u;
    } else {
        const float* km = (const float*)(p.ws + WS_KMEAN) + (((size_t)b * 8 + h) * 16) * 64; const float* relb = p.in[I_RELB];
        for (int i = tid; i < 16 * 64; i += NTHREADS) kms[i] = km[i];
        if (tid < 128) { int bk = tid; if (tid >= 16) { bk = 16 + (int)(logf((float)tid / 16.0f) / 2.0794415416798357f * 16.0f); bk = bk > 31 ? 31 : bk; } tbl[tid] = relb[bk * 8 + h] * LOG2E; }
        c31 = relb[31 * 8 + h] * LOG2E;
        for (int bk = 0; bk < 32; ++bk) bmax = fmaxf(bmax, relb[bk * 8 + h] * LOG2E);
        __syncthreads();
        if (tid < 256) {
            const bf16_t* qp = Qg + (rowbase + qb * 256 + tid) * DM + hcol; float qv[64];
#pragma unroll
            for (int c = 0; c < 8; ++c) { const u32x4 v = *(const u32x4*)(qp + c * 8);
#pragma unroll
                for (int j = 0; j < 4; ++j) { qv[c * 8 + 2 * j] = bf_lo(v[j]); qv[c * 8 + 2 * j + 1] = bf_hi(v[j]); } }
            float v1 = -INFINITY, v2 = -INFINITY, v3 = -INFINITY; int i1 = -1, i2 = -1, i3 = -1;
            for (int j = 0; j < qb; ++j) { float d = 0.f;
#pragma unroll
                for (int c = 0; c < 16; ++c) { const f32x4 kv = *(const LAS f32x4*)(kms + j * 64 + c * 4); d += qv[4 * c] * kv[0] + qv[4 * c + 1] * kv[1] + qv[4 * c + 2] * kv[2] + qv[4 * c + 3] * kv[3]; }
                if (d > v1) { v3 = v2; i3 = i2; v2 = v1; i2 = i1; v1 = d; i1 = j; } else if (d > v2) { v3 = v2; i3 = i2; v2 = d; i2 = j; } else if (d > v3) { v3 = d; i3 = j; } }
            unsigned mask = 0u; if (i1 >= 0) mask |= 1u << i1; if (i2 >= 0) mask |= 1u << i2; if (i3 >= 0) mask |= 1u << i3;
            sel[tid] = mask | (1u << qb);
        }
    }
    const int vswz = (skey ^ (sch << 3));
#define ATT_STORE1(slot, kreg, vreg) do { *(LAS u32x4*)(Ks + (slot) * 4608 + skey * 72 + sch * 8) = kreg; \
        _Pragma("unroll") for (int i_ = 0; i_ < 4; ++i_) { Vt[(slot) * 4608 + (sch * 8 + 2 * i_) * 72 + vswz] = (bf16_t)(vreg[i_] & 0xffffu); Vt[(slot) * 4608 + (sch * 8 + 2 * i_ + 1) * 72 + vswz] = (bf16_t)(vreg[i_] >> 16); } } while (0)
#define ATT_STORE(buf) do { ATT_STORE1((buf) * 2, kreg[0], vreg[0]); ATT_STORE1((buf) * 2 + 1, kreg[1], vreg[1]); } while (0)
    ATT_STORE(0);
    __syncthreads();
    if (tid < 64) { float pm = 0.f; for (int t = 0; t <= tid; ++t) pm = fmaxf(pm, kpms[64 + t]); kpms[tid] = sqrtf(pm) * 1.002f; }
    __syncthreads();
    f32x4 o[4][2];
#pragma unroll
    for (int db = 0; db < 4; ++db) { o[db][0] = (f32x4){0.f, 0.f, 0.f, 0.f}; o[db][1] = (f32x4){0.f, 0.f, 0.f, 0.f}; }
    float lrow[2] = {0.f, 0.f};
    float fq2[2] = {0.f, 0.f}; unsigned selm[2] = {0u, 0u};
    if (!MOBA) { fq2[0] = Fs[qb * 256 + 32 * w + fr]; fq2[1] = Fs[qb * 256 + 32 * w + 16 + fr]; }
    else { selm[0] = sel[32 * w + fr]; selm[1] = sel[32 * w + 16 + fr]; }
    const int qloc = 32 * w + fr;
    float mref[2], fq0 = 0.f; bool wdone = false;
    {
        float sq[2] = {0.f, 0.f};
#pragma unroll
        for (int jb = 0; jb < 2; ++jb)
#pragma unroll
            for (int ks = 0; ks < 2; ++ks) { const u32x4 qv = __builtin_bit_cast(u32x4, qf[jb][ks]);
#pragma unroll
                for (int j = 0; j < 4; ++j) { const float a = bf_lo(qv[j]), c = bf_hi(qv[j]); sq[jb] += a * a + c * c; } }
        const float kall = kpms[NT - 1];
#pragma unroll
        for (int jb = 0; jb < 2; ++jb) { float v = sq[jb]; v += __shfl_xor(v, 16); v += __shfl_xor(v, 32); mref[jb] = sqrtf(v) * 1.002f * kall + (MOBA ? bmax : 0.f); }
        if (!MOBA) fq0 = Fs[qb * 256 + 32 * w];
    }
    LAS unsigned char* listq = (LAS unsigned char*)(lds3 + 80000); LAS unsigned char* cntw = (LAS unsigned char*)(lds3 + 85120); LAS int* njs = (LAS int*)(lds3 + 85248); LAS float* mrefs = (LAS float*)(lds3 + 84096); LAS float* pst = (LAS float*)(lds3 + 93184);
    int qpl[2] = {qloc, qloc + 16}; bool qv[2] = {true, true}; float mrc[2] = {mref[0], mref[1]};
    if (MOBA) {
        for (int i = tid; i < 256 * 68; i += NTHREADS) pst[i] = 0.f;
        if (fq == 0) { mrefs[32 * w + fr] = mref[0]; mrefs[32 * w + 16 + fr] = mref[1]; }
        const unsigned my = sel[32 * w + (lane & 31)];
        for (int j = 0; j < qb; ++j) { const bool bit = (lane < 32) && ((my >> j) & 1u); const unsigned M = (unsigned)__ballot(bit); if (lane == 0) cntw[w * 16 + j] = (unsigned char)__builtin_popcount(M); }
        __syncthreads();
        for (int j = 0; j < qb; ++j) { const bool bit = (lane < 32) && ((my >> j) & 1u); const unsigned M = (unsigned)__ballot(bit);
            int base = 0, tot = 0;
#pragma unroll
            for (int w2 = 0; w2 < 8; ++w2) { const int c = cntw[w2 * 16 + j]; if (w2 < w) base += c; tot += c; }
            if (bit) listq[j * 256 + base + __builtin_popcount(M & ((1u << (lane & 31)) - 1u))] = (unsigned char)(32 * w + (lane & 31));
            if (tid == 0) njs[j] = tot; }
        __syncthreads();
    }
    bf16x8 qn[2][2] = {{qf[0][0], qf[0][1]}, {qf[1][0], qf[1][1]}};
#define ATT_QPREF(jj) do { if (MOBA && (jj) >= 0) { const int nj_ = __builtin_amdgcn_readfirstlane(njs[jj]); if (32 * w < nj_) { \
        _Pragma("unroll") for (int jb = 0; jb < 2; ++jb) { const int slot_ = 32 * w + 16 * jb + fr; const int q_ = (slot_ < nj_) ? (int)listq[(jj) * 256 + slot_] : 0; \
            _Pragma("unroll") for (int ks = 0; ks < 2; ++ks) qn[jb][ks] = *(const bf16x8*)(Qg + (rowbase + qb * 256 + q_) * DM + hcol + 32 * ks + 8 * fq); } } } } while (0)
    for (int st = 0; st < NT / 2; ++st) {
        const int buf = st & 1;
        if (st + 1 < NT / 2) {
#pragma unroll
            for (int sb = 0; sb < 2; ++sb) { const size_t o_ = (size_t)(NT - 1 - (2 * st + 2 + sb)) * 64 * DM; kreg[sb] = *(const u32x4*)(kp + o_); vreg[sb] = *(const u32x4*)(vp + o_); } }
      for (int sub = 0; sub < 2; ++sub) {
        const int it = 2 * st + sub, t = NT - 1 - it, slot = buf * 2 + sub;
        const int tl = t - 4 * qb;
        if (!MOBA && !wdone && (fq0 - Fs[64 * t + 63]) < -136.f) wdone = true;
        bool active = (tl <= (w >> 1)) && !wdone;
        if (MOBA && it == 0) ATT_QPREF(qb - 1);
        if (MOBA && tl < 0) {
            const int j = t >> 2; const int nj = __builtin_amdgcn_readfirstlane(njs[j]);
            active = (32 * w < nj);
            if (active && (t & 3) == 3) {
#pragma unroll
                for (int jb = 0; jb < 2; ++jb) { const int slot = 32 * w + 16 * jb + fr; qv[jb] = slot < nj; const int q = qv[jb] ? (int)listq[j * 256 + slot] : 0; qpl[jb] = q; mrc[jb] = mrefs[q];
#pragma unroll
                    for (int ks = 0; ks < 2; ++ks) qf[jb][ks] = qn[jb][ks]; }
            }
            if ((t & 3) == 3) ATT_QPREF(j - 1);
        }
        if (active) {
            const bool diag = (tl == (w >> 1));
            f32x4 s[4][2];
            bool band = false;
            if (!MOBA) {
                const float f0 = fq2[0] - mref[0], f1 = fq2[1] - mref[1];
#pragma unroll
                for (int kb = 0; kb < 4; ++kb) { const f32x4 fk = *(const LAS f32x4*)(Fs + 64 * t + 16 * kb + 4 * fq); s[kb][0] = f0 - fk; s[kb][1] = f1 - fk; }
            } else {
                band = (t >> 2) >= qb - 1;
                const float cc = band ? 0.f : c31;
                const float c0 = (qv[0] ? cc : NEGBIG) - mrc[0], c1 = (qv[1] ? cc : NEGBIG) - mrc[1];
#pragma unroll
                for (int kb = 0; kb < 4; ++kb) { s[kb][0] = (f32x4){c0, c0, c0, c0}; s[kb][1] = (f32x4){c1, c1, c1, c1}; }
            }
            { bf16x8 kf[4][2];
#pragma unroll
            for (int kb = 0; kb < 4; ++kb)
#pragma unroll
                for (int ks = 0; ks < 2; ++ks) kf[kb][ks] = *(const LAS bf16x8*)(Ks + slot * 4608 + (16 * kb + fr) * 72 + 32 * ks + 8 * fq);
            __builtin_amdgcn_sched_barrier(0);
#pragma unroll
            for (int kb = 0; kb < 4; ++kb)
#pragma unroll
                for (int ks = 0; ks < 2; ++ks) {
                    s[kb][0] = __builtin_amdgcn_mfma_f32_16x16x32_bf16(kf[kb][ks], qf[0][ks], s[kb][0], 0, 0, 0); s[kb][1] = __builtin_amdgcn_mfma_f32_16x16x32_bf16(kf[kb][ks], qf[1][ks], s[kb][1], 0, 0, 0); }
            __builtin_amdgcn_sched_barrier(0); }
            if (MOBA && band) {
                asm volatile("" ::: "memory");
#pragma unroll
                for (int kb = 0; kb < 4; ++kb)
#pragma unroll
                    for (int jb = 0; jb < 2; ++jb)
#pragma unroll
                        for (int r = 0; r < 4; ++r) { int d = (256 * qb + qpl[jb]) - (64 * t + 16 * kb + 4 * fq + r); d = d < 0 ? 0 : (d > 127 ? 127 : d); s[kb][jb][r] += tbl[d]; }
            }
            if (diag) {
                asm volatile("" ::: "memory");
#pragma unroll
                for (int kb = 0; kb < 4; ++kb)
#pragma unroll
                    for (int jb = 0; jb < 2; ++jb)
#pragma unroll
                        for (int r = 0; r < 4; ++r) { if ((64 * tl + 16 * kb + 4 * fq + r) > (MOBA ? qpl[jb] : qloc + 16 * jb)) s[kb][jb][r] = NEGBIG; }
            }
            {
#pragma unroll
            for (int jb = 0; jb < 2; ++jb) { float ls = 0.f;
#pragma unroll
                for (int kb = 0; kb < 4; ++kb)
#pragma unroll
                    for (int r = 0; r < 4; ++r) { const float e = __builtin_amdgcn_exp2f(s[kb][jb][r]); s[kb][jb][r] = e; ls += e; }
                lrow[jb] += ls; }
            { u32x2 vlo[2][4], vhi[2][4];
#pragma unroll
            for (int ks2 = 0; ks2 < 2; ++ks2)
#pragma unroll
                for (int db = 0; db < 4; ++db) { const int d = 32 * (db >> 1) + 8 * (fr >> 2) + 4 * (db & 1) + (fr & 3);        const int kx = (32 * ks2 + 4 * fq) ^ (((d >> 3) & 7) << 3);
                    vlo[ks2][db] = *(const LAS u32x2*)(Vt + slot * 4608 + d * 72 + kx); vhi[ks2][db] = *(const LAS u32x2*)(Vt + slot * 4608 + d * 72 + (kx ^ 16)); }
            bf16x8 pf[2][2];
#pragma unroll
            for (int ks2 = 0; ks2 < 2; ++ks2)
#pragma unroll
                for (int jb = 0; jb < 2; ++jb) { const f32x4 a = s[2 * ks2][jb], c = s[2 * ks2 + 1][jb]; u32x4 pw; pw.x = pk2(a[0], a[1]); pw.y = pk2(a[2], a[3]); pw.z = pk2(c[0], c[1]); pw.w = pk2(c[2], c[3]); pf[ks2][jb] = __builtin_bit_cast(bf16x8, pw); }
            __builtin_amdgcn_sched_barrier(0);
#pragma unroll
            for (int ks2 = 0; ks2 < 2; ++ks2)
#pragma unroll
                for (int db = 0; db < 4; ++db) { u32x4 vv; vv.x = vlo[ks2][db].x; vv.y = vlo[ks2][db].y; vv.z = vhi[ks2][db].x; vv.w = vhi[ks2][db].y; const bf16x8 vf = __builtin_bit_cast(bf16x8, vv);
                    o[db][0] = __builtin_amdgcn_mfma_f32_16x16x32_bf16(vf, pf[ks2][0], o[db][0], 0, 0, 0); o[db][1] = __builtin_amdgcn_mfma_f32_16x16x32_bf16(vf, pf[ks2][1], o[db][1], 0, 0, 0); }
            __builtin_amdgcn_sched_barrier(0); }
            }
        }
        if (MOBA && (t & 3) == 0 && (tl >= 0 || active)) {
#pragma unroll
            for (int jb = 0; jb < 2; ++jb) { float l = lrow[jb]; l += __shfl_xor(l, 16); l += __shfl_xor(l, 32);
                if (qv[jb]) { LAS float* st = pst + qpl[jb] * 68;
#pragma unroll
                    for (int db = 0; db < 4; ++db) { f32x4 ov = o[db][jb]; asm volatile("" : "+v"(ov)); f32x4 v = *(const LAS f32x4*)(st + 32 * (db >> 1) + 8 * fq + 4 * (db & 1)); v += ov; *(LAS f32x4*)(st + 32 * (db >> 1) + 8 * fq + 4 * (db & 1)) = v; }
                    if (fq == 0) st[64] += l; }
#pragma unroll
                for (int db = 0; db < 4; ++db) o[db][jb] = (f32x4){0.f, 0.f, 0.f, 0.f};
                lrow[jb] = 0.f; }
        }
      }
        if (st + 1 < NT / 2) ATT_STORE(buf ^ 1);
        if (!MOBA) { if (lane == 0) dflag[(st & 1) * 8 + w] = wdone ? 1u : 0u; }
        __syncthreads();
        if (!MOBA) { const u32x4 fa = *(const LAS u32x4*)(lds3 + 73728 + 16384 + 2048 + 512 + (st & 1) * 32), fb = *(const LAS u32x4*)(lds3 + 73728 + 16384 + 2048 + 512 + (st & 1) * 32 + 16);
            if ((fa[0] & fa[1] & fa[2] & fa[3] & fb[0] & fb[1] & fb[2] & fb[3]) != 0u) break; }
    }
#undef ATT_STORE
#undef ATT_STORE1
#undef ATT_QPREF
#pragma unroll
    for (int jb = 0; jb < 2; ++jb) { float l = lrow[jb]; l += __shfl_xor(l, 16); l += __shfl_xor(l, 32);
        if (MOBA) { const LAS float* st = pst + (qloc + 16 * jb) * 68; l = st[64];
#pragma unroll
            for (int db = 0; db < 4; ++db) o[db][jb] = *(const LAS f32x4*)(st + 32 * (db >> 1) + 8 * fq + 4 * (db & 1)); }
        const float inv = 1.0f / l;
        bf16_t* op = Og + (qrow0 + 16 * jb + fr) * DM + hcol + 8 * fq;
#pragma unroll
        for (int dp = 0; dp < 2; ++dp) { const f32x4 v0 = o[2 * dp][jb] * inv, v1 = o[2 * dp + 1][jb] * inv; u32x4 wv; wv.x = pk2(v0[0], v0[1]); wv.y = pk2(v0[2], v0[3]); wv.z = pk2(v1[0], v1[1]); wv.w = pk2(v1[2], v1[3]); *(u32x4*)(op + 32 * dp) = wv; } }
}
__device__ __forceinline__ void phase_attn(const Params& p, unsigned char* lds, LAS unsigned char* lds3) {
    for (int u = blockIdx.x; u < 2048; u += gridDim.x) {
        const int bx = u & 255, i = u >> 8; const int wv = (bx & 7) * 32 + (bx >> 3);
        const int combo = wv >> 2, quarter = wv & 3; const int k = i & 3;
        const int b = combo >> 3, h = ((combo & 7) + 2 * k + (i >> 2)) & 7;
        const int qb = (k == 0) ? quarter : (k == 1) ? 15 - quarter : (k == 2) ? 7 - quarter : 8 + quarter;
        if (i < 4) attn_unit<true>(lds, lds3, p, b, h, qb); else attn_unit<false>(lds, lds3, p, b, h, qb);
    }
    __syncthreads();
}

__device__ __forceinline__ void phase_final(const Params& p) {
    int tid_ = threadIdx.x; asm volatile("" : "+v"(tid_)); const int tid = tid_, lane = tid & 63, wave = tid >> 6;
    const int gw = blockIdx.x * NWAVES + wave, NGW = gridDim.x * NWAVES;
    const float* ssq = (const float*)(p.ws + WS_SSQ); const float* g = p.in[I_FING]; float* out = p.out;
    f32x4 gv[4];
#pragma unroll
    for (int j = 0; j < 4; ++j) gv[j] = ((const f32x4*)g)[lane + 64 * j];
    const bf16_t* hb = (const bf16_t*)(p.ws + WS_HB);
    u32x2 nh[4]; f32x4 ns = {0.f, 0.f, 0.f, 0.f};
    if (gw < MROWS) { const u32x2* hr = (const u32x2*)(hb + (size_t)gw * DM) + lane; ns = *(const f32x4*)(ssq + (size_t)gw * 4);
#pragma unroll
        for (int j = 0; j < 4; ++j) nh[j] = hr[64 * j]; }
    for (int m = gw; m < MROWS; m += NGW) {
        u32x2 ch[4]; const f32x4 cs = ns;
#pragma unroll
        for (int j = 0; j < 4; ++j) ch[j] = nh[j];
        if (m + NGW < MROWS) { const u32x2* hr = (const u32x2*)(hb + (size_t)(m + NGW) * DM) + lane; ns = *(const f32x4*)(ssq + (size_t)(m + NGW) * 4);
#pragma unroll
            for (int j = 0; j < 4; ++j) nh[j] = hr[64 * j]; }
        const float rs = __builtin_amdgcn_rsqf(((cs[0] + cs[1]) + (cs[2] + cs[3])) * (1.0f / 1024.0f) + 1e-6f); f32x4* xr = (f32x4*)(out + (size_t)m * DM) + lane;
#pragma unroll
        for (int j = 0; j < 4; ++j) { const u32x2 hv = ch[j]; const f32x4 v = {bf_lo(hv.x), bf_hi(hv.x), bf_lo(hv.y), bf_hi(hv.y)}; xr[64 * j] = v * rs * gv[j]; } }
}

#define XB_TMO      128
#define XB_XCNT(j)  (256  + 64 * (j))
#define XB_XSUB(j)  (1280 + 64 * (j))
#define XB_XGEN(j)  (2304 + 64 * (j))
#define XB_TOP      3328
#define XB_TOPGEN   3392
#define XCD_BAR_WORDS 3456
#define XB_SPIN_CAP (1u << 18)

__device__ __forceinline__ unsigned xb_ld(unsigned* p)              { return __hip_atomic_load(p, __ATOMIC_RELAXED, __HIP_MEMORY_SCOPE_AGENT); }
__device__ __forceinline__ unsigned xb_add(unsigned* p, unsigned v) { return __hip_atomic_fetch_add(p, v, __ATOMIC_RELAXED, __HIP_MEMORY_SCOPE_AGENT); }
__device__ __forceinline__ unsigned xb_xcc_id() { return (unsigned)__builtin_amdgcn_s_getreg((3 << 11) | 20) & 0xFu; }
#define XB_SPIN(cond, bar) do { unsigned _sp = 0; while (cond) { __builtin_amdgcn_s_sleep(1); \
    if ((++_sp & 255u) == 0u) { if (xb_ld(&(bar)[XB_TMO])) break; if (_sp > XB_SPIN_CAP) { atomicAdd(&(bar)[XB_TMO], 1u); break; } } } } while (0)

struct XcdBarrier {
    unsigned* bar; unsigned x;
    volatile LAS unsigned* st;
};

__device__ __forceinline__ XcdBarrier xcd_barrier_post(unsigned* bar, volatile LAS unsigned* st) {
    XcdBarrier b; b.bar = bar; b.x = xb_xcc_id(); b.st = st;
    if (threadIdx.x == 0) (void)xb_add(&bar[XB_XCNT(b.x)], 1u);
    return b;
}
__device__ __forceinline__ void xcd_barrier_complete(unsigned* bar, unsigned x, unsigned& nloc, unsigned& nx) {
    const unsigned G = gridDim.x * gridDim.y * gridDim.z;
    unsigned sum, cnt, mine, sp = 0u;
    for (;;) {
        sum = 0u; cnt = 0u; mine = 0u;
#pragma unroll
        for (unsigned j = 0; j < 16; ++j) { const unsigned c = xb_ld(&bar[XB_XCNT(j)]); sum += c; cnt += (c > 0u) ? 1u : 0u; mine = (j == x) ? c : mine; }
        if (sum == G) break;
        __builtin_amdgcn_s_sleep(1);
        if ((++sp & 255u) == 0u) { if (xb_ld(&bar[XB_TMO])) break; if (sp > XB_SPIN_CAP) { atomicAdd(&bar[XB_TMO], 1u); break; } }
    }
    nloc = mine > 0u ? mine : 1u; nx = cnt > 0u ? cnt : 1u;
}

__device__ __forceinline__ void xcd_barrier(const XcdBarrier& b) {
    asm volatile("s_waitcnt vmcnt(0)" ::: "memory");
    __syncthreads();
    if (threadIdx.x == 0) {
        unsigned* bar = b.bar;
        __builtin_amdgcn_s_waitcnt(0);
        unsigned nloc = b.st[0], nx = b.st[1];
        if (nloc == 0u) { xcd_barrier_complete(bar, b.x, nloc, nx); b.st[0] = nloc; b.st[1] = nx; }
        const unsigned old = xb_add(&bar[XB_XSUB(b.x)], 1u);
        const unsigned gen = old / nloc;
        if (old + 1u == (gen + 1u) * nloc) {
            __builtin_amdgcn_fence(__ATOMIC_RELEASE, "agent");
            asm volatile("s_waitcnt vmcnt(0)" ::: "memory");
            const unsigned og = xb_add(&bar[XB_TOP], 1u);
            const unsigned tg = og / nx;
            if (og + 1u == (tg + 1u) * nx) xb_add(&bar[XB_TOPGEN], 1u);
            else XB_SPIN(xb_ld(&bar[XB_TOPGEN]) == tg, bar);
            __builtin_amdgcn_fence(__ATOMIC_ACQUIRE, "agent");
            xb_add(&bar[XB_XGEN(b.x)], 1u);
            asm volatile("s_waitcnt vmcnt(0)" ::: "memory");
        } else {
            XB_SPIN(xb_ld(&bar[XB_XGEN(b.x)]) == gen, bar);
            __builtin_amdgcn_fence(__ATOMIC_ACQUIRE, "agent");
            asm volatile("s_waitcnt vmcnt(0)" ::: "memory");
        }
    }
    __syncthreads();
}

constexpr size_t WS_BAR = 100 * MiB + 512 * 1024;
typedef const Params __attribute__((address_space(4)))* KPtr;
__device__ __forceinline__ Params load_params(KPtr kp) { Params p;
#pragma unroll
    for (int i = 0; i < 17; ++i) p.in[i] = kp->in[i];
    p.out = kp->out; p.ws = kp->ws; p.ph_lo = kp->ph_lo; p.ph_hi = kp->ph_hi; return p; }
__global__ void __launch_bounds__(NTHREADS, 2) fwd_megakernel(Params p_arg) {
    extern __shared__ __attribute__((aligned(16))) unsigned char lds[];
    cg::grid_group grid = cg::this_grid();
    PG8_LAS unsigned char* lds3 = (PG8_LAS unsigned char*)lds;
    const KPtr kp0 = (KPtr)__builtin_amdgcn_kernarg_segment_ptr();
    const int ph_lo = p_arg.ph_lo, ph_hi = p_arg.ph_hi;
    volatile LAS unsigned* bst = (volatile LAS unsigned*)(lds3 + 163776);
    if (threadIdx.x < 2) bst[threadIdx.x] = 0u;
    __syncthreads();
    XcdBarrier xbar; xbar.bar = nullptr; xbar.x = 0; xbar.st = bst;
    int ph = 0;
#define PH_BEGIN if (ph >= ph_lo && ph < ph_hi) { KPtr kp_ = kp0; asm volatile("" : "+s"(kp_)); const Params p = load_params(kp_); unsigned char* ws = p.ws; \
    bf16_t* hb = (bf16_t*)(ws + WS_HB); float* ssq = (float*)(ws + WS_SSQ); bf16_t* R1 = (bf16_t*)(ws + WS_R1); bf16_t* R2 = (bf16_t*)(ws + WS_R2); (void)hb; (void)ssq; (void)R1; (void)R2;
#define PH_END_LOCAL asm volatile("s_waitcnt vmcnt(0)" ::: "memory"); __syncthreads(); }
#define PH_END   if (ph + 1 < ph_hi) { if (ph == 0) { grid.sync(); xbar = xcd_barrier_post((unsigned*)(ws + WS_BAR), bst); } else xcd_barrier(xbar); } } ++ph;
    PH_BEGIN { if (blockIdx.x == 0) { unsigned* bw = (unsigned*)(ws + WS_BAR); for (int i = threadIdx.x; i < XCD_BAR_WORDS; i += NTHREADS) bw[i] = 0u; } phase_prologue(p, lds); } PH_END
    for (int layer = 0; layer < 4; ++layer) {
        const int e = layer >> 1;
        if ((layer & 1) == 0) {
            PH_BEGIN { pg8::Gemm g{hb, (const bf16_t*)(ws + WS_EVIN) + (size_t)e * EV_N * DM, MROWS, EV_N, DM}; pg8::StaticOrder S; S.init(MROWS, EV_N, gridDim.x, blockIdx.x);
                pg8::EpiScaleBf16 E{R1, EV_N, ssq, 0, 0, 0, 1.f, -1, nullptr, nullptr};
                pg8::gemm_phase<pg8::EpiScaleBf16, pg8::StaticOrder, true, true>(lds3, g, S, E); } PH_END
            PH_BEGIN phase_evmix(p, lds, e); PH_END
            PH_BEGIN { pg8::Gemm g{R2, (const bf16_t*)(ws + WS_EVOUT) + (size_t)e * DM * DM, MROWS, DM, DM}; pg8::StaticOrder S; S.init(MROWS, DM, gridDim.x, blockIdx.x);
                pg8::EpiResid E{(layer == 0) ? p.in[I_X] : nullptr, hb, ssq, 0, (PG8_LAS float*)(lds3 + 131072)};
                pg8::gemm_phase<pg8::EpiResid, pg8::StaticOrder, true, true>(lds3, g, S, E); } PH_END
        } else {
            PH_BEGIN { pg8::Gemm g{hb, (const bf16_t*)(ws + WS_ODIN) + (size_t)e * OD_NP * DM, MROWS, OD_NP, DM}; pg8::StaticOrder S; S.init(MROWS, OD_NP, gridDim.x, blockIdx.x);
                pg8::EpiScaleBf16 E{R1, DM, ssq, 0, DM, (size_t)MROWS * DM, 0.125f * LOG2E, 12, (float*)(ws + WS_LF), p.in[I_ODBF] + e * 8};
                pg8::gemm_phase<pg8::EpiScaleBf16, pg8::StaticOrder, true, true>(lds3, g, S, E); } PH_END
            PH_BEGIN phase_scan_kmean(p, lds); PH_END
            PH_BEGIN phase_attn(p, lds, lds3); PH_END
            PH_BEGIN { pg8::Gemm g{R2, (const bf16_t*)(ws + WS_ODOUT) + (size_t)e * DM * DM, MROWS, DM, DM}; pg8::StaticOrder S; S.init(MROWS, DM, gridDim.x, blockIdx.x);
                pg8::EpiResid E{(layer == 0) ? p.in[I_X] : nullptr, hb, ssq, 0, (PG8_LAS float*)(lds3 + 131072)};
                pg8::gemm_phase<pg8::EpiResid, pg8::StaticOrder, true, true>(lds3, g, S, E); } PH_END
        }
        PH_BEGIN { pg8::Gemm g{hb, (const bf16_t*)(ws + WS_FFIN) + (size_t)layer * FF_N * DM, MROWS, FF_N, DM}; pg8::StaticOrder S; S.init(MROWS, FF_N, gridDim.x, blockIdx.x);
            float* UH = (float*)(ws + WS_R2);
            pg8::EpiFfnAct E{R1, ssq, p.in[I_FFCONVW] + (size_t)layer * 3 * DFF, p.in[I_FFCONVB] + (size_t)layer * DFF, UH, UH + (size_t)128 * 2 * DFF, UH + (size_t)2 * 128 * 2 * DFF, (PG8_LAS float*)(lds3 + 131072)};
            pg8::gemm_phase<pg8::EpiFfnAct, pg8::StaticOrder, true, true>(lds3, g, S, E); } PH_END
        PH_BEGIN { pg8::StaticOrder S; S.init(MROWS, DM, gridDim.x, blockIdx.x); pg8::Unit fu; int lastpm = -1;
            for (int i = 0; S.next(i, fu); ++i) { if (fu.pm != lastpm) ffnfix_pm(p, layer, fu.pm); lastpm = fu.pm; } } PH_END_LOCAL
        PH_BEGIN { pg8::Gemm g{R1, (const bf16_t*)(ws + WS_FFOUT) + (size_t)layer * DM * DFF, MROWS, DM, DFF}; pg8::StaticOrder S; S.init(MROWS, DM, gridDim.x, blockIdx.x);
            pg8::EpiResid E{nullptr, hb, ssq, 0, (PG8_LAS float*)(lds3 + 131072)};
            pg8::gemm_phase<pg8::EpiResid, pg8::StaticOrder, true, true>(lds3, g, S, E); } PH_END
    }
    PH_BEGIN phase_final(p); PH_END
}
constexpr int N_PHASES = 1 + 2 * (3 + 2) + 2 * (4 + 2) + 1;

#ifndef ONE_LAUNCH
#define ONE_LAUNCH 1
#endif
extern "C" void kernel_launch(void* const* d_in, const int* in_sizes, int n_in, void* d_out, int out_size, void* d_ws, size_t ws_size, hipStream_t stream) {
    static int grid = 0;
    if (grid == 0) {
        if (n_in != 17 || out_size != MROWS * DM || ws_size < WS_END) { fprintf(stderr, "kernel_launch: unexpected shapes (n_in %d out %d ws %zu)\n", n_in, out_size, ws_size); grid = -1; return; }
        int dev = 0, cus = 0, per_cu = 0;
        hipGetDevice(&dev); hipDeviceGetAttribute(&cus, hipDeviceAttributeMultiprocessorCount, dev);
        hipFuncSetAttribute((const void*)fwd_megakernel, hipFuncAttributeMaxDynamicSharedMemorySize, LDS_BYTES);
        hipOccupancyMaxActiveBlocksPerMultiprocessor(&per_cu, (const void*)fwd_megakernel, NTHREADS, LDS_BYTES);
        if (per_cu < 1) { fprintf(stderr, "kernel_launch: occupancy query says %d blocks per CU\n", per_cu); per_cu = 1; }
        (void)hipGetLastError();
        grid = cus;
    }
    if (grid < 0) return;
    Params p{};
    for (int i = 0; i < 17; ++i) p.in[i] = (const float*)d_in[i];
    p.out = (float*)d_out; p.ws = (unsigned char*)d_ws;
#if ONE_LAUNCH
    p.ph_lo = 0; p.ph_hi = N_PHASES;
    void* args[] = {&p};
    hipError_t e = hipLaunchCooperativeKernel((const void*)fwd_megakernel, dim3(grid), dim3(NTHREADS), args, LDS_BYTES, stream);
    if (e != hipSuccess) fprintf(stderr, "cooperative launch failed: %s (grid %d)\n", hipGetErrorString(e), grid);
#else
    for (int ph = 0; ph < N_PHASES; ++ph) { p.ph_lo = ph; p.ph_hi = ph + 1; hipLaunchKernelGGL(fwd_megakernel, dim3(grid), dim3(NTHREADS), LDS_BYTES, stream, p); }
#endif
}
```
